# Optimizing an MI355X kernel written in HIP

```python
import numpy as np
import jax
import jax.numpy as jnp
from jax import lax

D_MODEL = 2048
BATCH = 4
SEQ = 2048
DEPTH = 2

N_MIXERS = 4
HEAD_DIM = 128
GROUP_WIDTH = D_MODEL // N_MIXERS
MIX_WIDTH = N_MIXERS * GROUP_WIDTH
N_HEADS = GROUP_WIDTH // HEAD_DIM
Q_BLOCK = 128
ROPE_THETA = 10000.0
RMS_EPS = 1e-6
NEG_INF = -1e30

CMP_LEN = 32
CMP_STRIDE = 16
CMP_HIDDEN = HEAD_DIM
SEL_LEN = 64
SEL_TOPN = 16
WINDOW = 512
FORCED_BONUS = 1e6

MLA_Q_RANK = 384
MLA_KV_RANK = 128
MLA_NOPE = 128
MLA_ROPE = 64
MLA_V = 128

IN_SPLITS = (
    ("sb_q", GROUP_WIDTH), ("sb_k", GROUP_WIDTH), ("sb_v", GROUP_WIDTH), ("sb_gate", GROUP_WIDTH),
    ("nsa_q", GROUP_WIDTH), ("nsa_k_cmp", HEAD_DIM), ("nsa_v_cmp", HEAD_DIM),
    ("nsa_k_sel", HEAD_DIM), ("nsa_v_sel", HEAD_DIM), ("nsa_k_win", HEAD_DIM), ("nsa_v_win", HEAD_DIM),
    ("nsa_branch", 3 * N_HEADS), ("nsa_gate", GROUP_WIDTH),
    ("fox_q", GROUP_WIDTH), ("fox_k", GROUP_WIDTH), ("fox_v", GROUP_WIDTH), ("fox_f", N_HEADS),
    ("fox_gate", GROUP_WIDTH),
    ("mla_cq", MLA_Q_RANK), ("mla_ckv", MLA_KV_RANK), ("mla_k_rope", MLA_ROPE), ("mla_gate", GROUP_WIDTH),
)
IN_WIDTH = sum(width for _, width in IN_SPLITS)

kernel_name = "hybrid_sb_nsa_fox_mla_layer"


def rms_norm(x, g):
    xf = x.astype(jnp.float32)
    y = xf * lax.rsqrt(jnp.mean(xf * xf, axis=-1, keepdims=True) + RMS_EPS)
    return (y * g.astype(jnp.float32)).astype(x.dtype)


def apply_rope(x, pos):
    half = x.shape[-1] // 2
    inv_freq = ROPE_THETA ** (-jnp.arange(half, dtype=jnp.float32) / half)
    ang = pos.astype(jnp.float32)[:, None] * inv_freq[None, :]
    cos = jnp.cos(ang)[:, None, :]
    sin = jnp.sin(ang)[:, None, :]
    xf = x.astype(jnp.float32)
    x1, x2 = xf[..., :half], xf[..., half:]
    return jnp.concatenate([x1 * cos - x2 * sin, x2 * cos + x1 * sin], axis=-1).astype(x.dtype)


def masked_softmax(z, mask):
    p = jax.nn.softmax(jnp.where(mask, z, NEG_INF), axis=-1)
    return jnp.where(mask, p, 0.0)


def sweep_query_blocks(block_fn, seq_len):
    out = lax.map(block_fn, jnp.arange(seq_len // Q_BLOCK))
    n_blocks, b, q, h, d = out.shape
    return jnp.moveaxis(out, 0, 1).reshape(b, n_blocks * q, h, d)


def split_columns(z):
    parts = {}
    offset = 0
    for name, width in IN_SPLITS:
        parts[name] = z[..., offset:offset + width]
        offset += width
    return parts


def stick_breaking_attention(q, k, v):
    B, S, H, d = q.shape
    scale = d ** -0.5
    kpos = jnp.arange(S)

    def block(i):
        s0 = i * Q_BLOCK
        qb = lax.dynamic_slice_in_dim(q, s0, Q_BLOCK, axis=1)
        qpos = s0 + jnp.arange(Q_BLOCK)
        z = jnp.einsum("bqhd,bshd->bhqs", qb, k).astype(jnp.float32) * scale
        earlier = kpos[None, :] < qpos[:, None]
        log_keep = jnp.where(earlier, jax.nn.log_sigmoid(-z), 0.0)
        log_after = lax.cumsum(log_keep, axis=3, reverse=True) - log_keep
        w = jnp.where(earlier, jnp.exp(jax.nn.log_sigmoid(z) + log_after), 0.0)
        return jnp.einsum("bhqs,bshd->bqhd", w.astype(v.dtype), v)

    return sweep_query_blocks(block, S)


def compress_blocks(tok, pos_emb, w1, w2):
    B, S, d = tok.shape
    n_cmp = (S - CMP_LEN) // CMP_STRIDE + 1
    gather = np.arange(n_cmp)[:, None] * CMP_STRIDE + np.arange(CMP_LEN)[None, :]
    blocks = tok[:, gather] + pos_emb
    hidden = jax.nn.silu(blocks.reshape(B, n_cmp, CMP_LEN * d) @ w1)
    return hidden @ w2


def native_sparse_attention(q, kc_tok, vc_tok, ks, vs, kw, vw, branch_gates,
                            pos_k, w1_k, w2_k, pos_v, w1_v, w2_v, pos):
    B, S, H, d = q.shape
    scale = d ** -0.5
    n_cmp = (S - CMP_LEN) // CMP_STRIDE + 1
    n_sel = S // SEL_LEN
    top_n = min(SEL_TOPN, n_sel)
    cmp_start = np.arange(n_cmp) * CMP_STRIDE
    cmp_end = jnp.asarray(cmp_start + CMP_LEN - 1, dtype=jnp.int32)
    sel_start = np.arange(n_sel) * SEL_LEN
    overlap = np.clip(np.minimum(cmp_start[:, None] + CMP_LEN, sel_start[None, :] + SEL_LEN)
                      - np.maximum(cmp_start[:, None], sel_start[None, :]), 0, None)
    cmp_to_sel = jnp.asarray(overlap / CMP_LEN, dtype=jnp.float32)

    q = apply_rope(q, pos)
    kc = compress_blocks(kc_tok, pos_k, w1_k, w2_k)
    kc = apply_rope(kc[:, :, None, :], cmp_end)[:, :, 0, :]
    vc = compress_blocks(vc_tok, pos_v, w1_v, w2_v)
    ks = apply_rope(ks[:, :, None, :], pos)[:, :, 0, :]
    kw = apply_rope(kw[:, :, None, :], pos)[:, :, 0, :]
    ks_blocks = ks.reshape(B, n_sel, SEL_LEN, d)
    vs_blocks = vs.reshape(B, n_sel, SEL_LEN, d)
    kw_pad = jnp.pad(kw, ((0, 0), (WINDOW, 0), (0, 0)))
    vw_pad = jnp.pad(vw, ((0, 0), (WINDOW, 0), (0, 0)))
    sel_ids = jnp.arange(n_sel)
    gather_blocks = jax.vmap(lambda blocks, ids: blocks[ids])

    def block(i):
        s0 = i * Q_BLOCK
        qb = lax.dynamic_slice_in_dim(q, s0, Q_BLOCK, axis=1)
        gb = lax.dynamic_slice_in_dim(branch_gates, s0, Q_BLOCK, axis=1)
        qpos = s0 + jnp.arange(Q_BLOCK)
        zc = jnp.einsum("bqhd,bnd->bhqn", qb, kc).astype(jnp.float32) * scale
        pc = masked_softmax(zc, cmp_end[None, :] <= qpos[:, None])
        o_cmp = jnp.einsum("bhqn,bnd->bqhd", pc.astype(vc.dtype), vc)
        imp = jnp.einsum("bhqn,ns->bqs", pc, cmp_to_sel)
        cur = qpos // SEL_LEN
        valid = sel_ids[None, :] <= cur[:, None]
        forced = ((sel_ids[None, :] == 0) | (sel_ids[None, :] == cur[:, None])
                  | (sel_ids[None, :] == cur[:, None] - 1))
        score = jnp.where(valid, jnp.where(forced, FORCED_BONUS, imp), NEG_INF)
        _, idx = lax.top_k(score, top_n)
        kg = gather_blocks(ks_blocks, idx)
        vg = gather_blocks(vs_blocks, idx).reshape(B, Q_BLOCK, top_n * SEL_LEN, d)
        tok = idx[..., None] * SEL_LEN + jnp.arange(SEL_LEN)
        sel_mask = (tok <= qpos[None, :, None, None]).reshape(B, 1, Q_BLOCK, top_n * SEL_LEN)
        zs = jnp.einsum("bqhd,bqnld->bhqnl", qb, kg).astype(jnp.float32)
        zs = zs.reshape(B, H, Q_BLOCK, top_n * SEL_LEN) * scale
        ps = masked_softmax(zs, sel_mask)
        o_slc = jnp.einsum("bhqm,bqmd->bqhd", ps.astype(vg.dtype), vg)
        kwb = lax.dynamic_slice_in_dim(kw_pad, s0, WINDOW + Q_BLOCK, axis=1)
        vwb = lax.dynamic_slice_in_dim(vw_pad, s0, WINDOW + Q_BLOCK, axis=1)
        kpos = s0 - WINDOW + jnp.arange(WINDOW + Q_BLOCK)
        win_mask = ((kpos[None, :] >= 0) & (kpos[None, :] <= qpos[:, None])
                    & (kpos[None, :] > qpos[:, None] - WINDOW))
        zw = jnp.einsum("bqhd,bkd->bhqk", qb, kwb).astype(jnp.float32) * scale
        pw = masked_softmax(zw, win_mask)
        o_win = jnp.einsum("bhqk,bkd->bqhd", pw.astype(vwb.dtype), vwb)
        return gb[..., 0:1] * o_cmp + gb[..., 1:2] * o_slc + gb[..., 2:3] * o_win

    return sweep_query_blocks(block, S)


def forgetting_attention(q, k, v, log_f):
    B, S, H, d = q.shape
    scale = d ** -0.5
    cum = jnp.cumsum(log_f, axis=1).transpose(0, 2, 1)
    kpos = jnp.arange(S)

    def block(i):
        s0 = i * Q_BLOCK
        qb = lax.dynamic_slice_in_dim(q, s0, Q_BLOCK, axis=1)
        cq = lax.dynamic_slice_in_dim(cum, s0, Q_BLOCK, axis=2)
        qpos = s0 + jnp.arange(Q_BLOCK)
        z = (jnp.einsum("bqhd,bshd->bhqs", qb, k).astype(jnp.float32) * scale
             + cq[..., None] - cum[:, :, None, :])
        p = masked_softmax(z, kpos[None, :] <= qpos[:, None])
        return jnp.einsum("bhqs,bshd->bqhd", p.astype(v.dtype), v)

    return sweep_query_blocks(block, S)


def latent_attention(c_q, c_kv, k_rope, q_norm_g, w_uq, kv_norm_g, w_ukv, pos):
    B, S, _ = c_q.shape
    q = (rms_norm(c_q, q_norm_g) @ w_uq).reshape(B, S, N_HEADS, MLA_NOPE + MLA_ROPE)
    q_nope = q[..., :MLA_NOPE]
    q_rot = apply_rope(q[..., MLA_NOPE:], pos)
    kv = (rms_norm(c_kv, kv_norm_g) @ w_ukv).reshape(B, S, N_HEADS, MLA_NOPE + MLA_V)
    k_nope, v = kv[..., :MLA_NOPE], kv[..., MLA_NOPE:]
    k_rot = apply_rope(k_rope[:, :, None, :], pos)[:, :, 0, :]
    scale = (MLA_NOPE + MLA_ROPE) ** -0.5
    kpos = jnp.arange(S)

    def block(i):
        s0 = i * Q_BLOCK
        qn = lax.dynamic_slice_in_dim(q_nope, s0, Q_BLOCK, axis=1)
        qr = lax.dynamic_slice_in_dim(q_rot, s0, Q_BLOCK, axis=1)
        qpos = s0 + jnp.arange(Q_BLOCK)
        z = (jnp.einsum("bqhd,bshd->bhqs", qn, k_nope)
             + jnp.einsum("bqhr,bsr->bhqs", qr, k_rot)).astype(jnp.float32) * scale
        p = masked_softmax(z, kpos[None, :] <= qpos[:, None])
        return jnp.einsum("bhqs,bshd->bqhd", p.astype(v.dtype), v)

    return sweep_query_blocks(block, S)


def hybrid_layer(x, pre_g, post_g, w_in, b_in, w_out, forget_bias,
                 pos_k, w1_k, w2_k, pos_v, w1_v, w2_v,
                 q_norm_g, w_uq, kv_norm_g, w_ukv):
    B, S, _ = x.shape
    pos = jnp.arange(S)
    h = rms_norm(x, pre_g)
    p = split_columns(h @ w_in + b_in)

    def heads(t):
        return t.reshape(B, S, N_HEADS, HEAD_DIM)

    o_sb = stick_breaking_attention(heads(p["sb_q"]), heads(p["sb_k"]), heads(p["sb_v"]))

    branch_gates = jax.nn.sigmoid(p["nsa_branch"].reshape(B, S, N_HEADS, 3))
    o_nsa = native_sparse_attention(heads(p["nsa_q"]), p["nsa_k_cmp"], p["nsa_v_cmp"],
                                    p["nsa_k_sel"], p["nsa_v_sel"], p["nsa_k_win"], p["nsa_v_win"],
                                    branch_gates, pos_k, w1_k, w2_k, pos_v, w1_v, w2_v, pos)

    log_f = jax.nn.log_sigmoid((p["fox_f"] + forget_bias).astype(jnp.float32))
    o_fox = forgetting_attention(heads(p["fox_q"]), heads(p["fox_k"]), heads(p["fox_v"]), log_f)

    o_mla = latent_attention(p["mla_cq"], p["mla_ckv"], p["mla_k_rope"],
                             q_norm_g, w_uq, kv_norm_g, w_ukv, pos)

    mix = jnp.concatenate([
        o_sb.reshape(B, S, GROUP_WIDTH) * jax.nn.silu(p["sb_gate"]),
        o_nsa.reshape(B, S, GROUP_WIDTH) * jax.nn.silu(p["nsa_gate"]),
        o_fox.reshape(B, S, GROUP_WIDTH) * jax.nn.silu(p["fox_gate"]),
        o_mla.reshape(B, S, GROUP_WIDTH) * jax.nn.silu(p["mla_gate"]),
    ], axis=-1)
    return x + rms_norm(mix @ w_out, post_g)


def setup_inputs(seed: int = 0) -> dict:
    key = jax.random.key(seed)
    ks = jax.random.split(key, 17)
    f32 = jnp.float32

    def normal(k, shape, scale):
        return jax.random.normal(k, shape, f32) * scale

    def gain(k, shape):
        return 1.0 + 0.02 * jax.random.normal(k, shape, f32)

    flat = CMP_LEN * HEAD_DIM
    return {
        "x": normal(ks[0], (BATCH, SEQ, D_MODEL), 1.0),
        "pre_norm_g": gain(ks[1], (DEPTH, D_MODEL)),
        "post_norm_g": gain(ks[2], (DEPTH, D_MODEL)),
        "w_in": normal(ks[3], (DEPTH, D_MODEL, IN_WIDTH), D_MODEL ** -0.5),
        "b_in": normal(ks[4], (DEPTH, IN_WIDTH), 0.02),
        "w_out": normal(ks[5], (DEPTH, MIX_WIDTH, D_MODEL), MIX_WIDTH ** -0.5),
        "fox_forget_bias": jax.random.uniform(ks[6], (DEPTH, N_HEADS), f32, 1.0, 4.0),
        "nsa_cmp_pos_k": normal(ks[7], (DEPTH, CMP_LEN, HEAD_DIM), 0.02),
        "nsa_cmp_w1_k": normal(ks[8], (DEPTH, flat, CMP_HIDDEN), flat ** -0.5),
        "nsa_cmp_w2_k": normal(ks[9], (DEPTH, CMP_HIDDEN, HEAD_DIM), CMP_HIDDEN ** -0.5),
        "nsa_cmp_pos_v": normal(ks[10], (DEPTH, CMP_LEN, HEAD_DIM), 0.02),
        "nsa_cmp_w1_v": normal(ks[11], (DEPTH, flat, CMP_HIDDEN), flat ** -0.5),
        "nsa_cmp_w2_v": normal(ks[12], (DEPTH, CMP_HIDDEN, HEAD_DIM), CMP_HIDDEN ** -0.5),
        "mla_q_norm_g": gain(ks[13], (DEPTH, MLA_Q_RANK)),
        "mla_w_uq": normal(ks[14], (DEPTH, MLA_Q_RANK, N_HEADS * (MLA_NOPE + MLA_ROPE)), MLA_Q_RANK ** -0.5),
        "mla_kv_norm_g": gain(ks[15], (DEPTH, MLA_KV_RANK)),
        "mla_w_ukv": normal(ks[16], (DEPTH, MLA_KV_RANK, N_HEADS * (MLA_NOPE + MLA_V)), MLA_KV_RANK ** -0.5),
    }


def reference(x, pre_norm_g, post_norm_g, w_in, b_in, w_out, fox_forget_bias,
              nsa_cmp_pos_k, nsa_cmp_w1_k, nsa_cmp_w2_k,
              nsa_cmp_pos_v, nsa_cmp_w1_v, nsa_cmp_w2_v,
              mla_q_norm_g, mla_w_uq, mla_kv_norm_g, mla_w_ukv):
    for l in range(DEPTH):
        x = hybrid_layer(x, pre_norm_g[l], post_norm_g[l], w_in[l], b_in[l], w_out[l],
                         fox_forget_bias[l],
                         nsa_cmp_pos_k[l], nsa_cmp_w1_k[l], nsa_cmp_w2_k[l],
                         nsa_cmp_pos_v[l], nsa_cmp_w1_v[l], nsa_cmp_w2_v[l],
                         mla_q_norm_g[l], mla_w_uq[l], mla_kv_norm_g[l], mla_w_ukv[l])
    return x
```

```cpp
#include <hip/hip_runtime.h>
#include <hip/hip_cooperative_groups.h>
#include <cstdio>
namespace cg = cooperative_groups;

typedef unsigned short u16;
typedef short bf16x8 __attribute__((ext_vector_type(8)));
typedef float f32x16 __attribute__((ext_vector_type(16)));
typedef float f32x4 __attribute__((ext_vector_type(4)));
typedef float f32x2 __attribute__((ext_vector_type(2)));
typedef unsigned u32x4 __attribute__((ext_vector_type(4)));
typedef unsigned u32x2 __attribute__((ext_vector_type(2)));
typedef __bf16 bf16x2_t __attribute__((ext_vector_type(2)));

#define DI __device__ __forceinline__

constexpr int S_ = 2048;
constexpr int T_ = 8192;
constexpr int D_ = 2048;
constexpr int NINO = 6992;
constexpr int NINP = 7040;
constexpr int NTHREADS = 512;
constexpr int VT = 256;
constexpr int HALF_BYTES = 73728;
constexpr int AOFF_K1 = 17408, AOFF_V0 = 34816, AOFF_V1 = 53248, AOFF_C = 71680, AOFF_QM = 72192, AOFF_HB = 72448, AOFF_ITEM = 72512, AOFF_DONE = 72576;
constexpr int VLD = 72;
constexpr int SMEM_BYTES = 2 * 512 * 72 * 2 + 2048;
constexpr int SH_OFF = 2 * 512 * 72 * 2 + 1024;
#ifndef DUP_SUB
#define DUP_SUB -1
#endif

struct P {
  const float *x, *pre_g, *post_g, *w_in, *b_in, *w_out, *fb, *pos_k, *w1_k, *w2_k, *pos_v, *w1_v, *w2_v, *qn_g, *w_uq, *kvn_g, *w_ukv;
  float* out;
  char* ws;
  int phase_lo, phase_hi;
};
constexpr size_t OFF_wt_in = 0ull;
constexpr size_t OFF_wt_out = 57671680ull;
constexpr size_t OFF_w1t = 74448896ull;
constexpr size_t OFF_w2t = 78643200ull;
constexpr size_t OFF_wuqt = 78774272ull;
constexpr size_t OFF_wukvt = 79953920ull;
constexpr size_t OFF_c1part = 80478208ull;
constexpr size_t OFF_bperm = 80543744ull;
constexpr size_t OFF_ropec = 80600064ull;
constexpr size_t OFF_ropes = 81124352ull;
constexpr size_t OFF_H = 81648640ull;
constexpr size_t OFF_X1 = 115203072ull;
constexpr size_t OFF_Y = 182311936ull;
constexpr size_t OFF_SBQ = 249420800ull;
constexpr size_t OFF_SBK = 257809408ull;
constexpr size_t OFF_SBVt = 266198016ull;
constexpr size_t OFF_NQ = 274586624ull;
constexpr size_t OFF_KCT = 282975232ull;
constexpr size_t OFF_VCT = 285137920ull;
constexpr size_t OFF_KSEL = 287300608ull;
constexpr size_t OFF_VSELt = 289397760ull;
constexpr size_t OFF_KWIN = 291494912ull;
constexpr size_t OFF_VWINt = 293592064ull;
constexpr size_t OFF_FQ = 295689216ull;
constexpr size_t OFF_FK = 304077824ull;
constexpr size_t OFF_FVt = 312466432ull;
constexpr size_t OFF_CQ = 320855040ull;
constexpr size_t OFF_CKV = 327146496ull;
constexpr size_t OFF_KR = 329243648ull;
constexpr size_t OFF_G = 330292224ull;
constexpr size_t OFF_MQ = 363846656ull;
constexpr size_t OFF_MKN = 376429568ull;
constexpr size_t OFF_MVt = 384818176ull;
constexpr size_t OFF_KC = 393206784ull;
constexpr size_t OFF_VCt = 393337856ull;
constexpr size_t OFF_MIX = 393468928ull;
constexpr size_t OFF_BR = 427023360ull;
constexpr size_t OFF_LOGF = 427416576ull;
constexpr size_t OFF_CUM = 427547648ull;
constexpr size_t OFF_FN = 427678720ull;
constexpr size_t OFF_ctr = 444455936ull;
constexpr size_t OFF_PART = OFF_ctr + 65536;
constexpr size_t WS_TOTAL_OLD = 444456192ull;


DI unsigned pk2(float a, float b) { f32x2 v = {a, b}; bf16x2_t r = __builtin_convertvector(v, bf16x2_t); return __builtin_bit_cast(unsigned, r); }
DI u16 f2bf(float a) { return (u16)(pk2(a, 0.f) & 0xffffu); }
DI float bf2f(u16 v) { return __uint_as_float(((unsigned)v) << 16); }
DI f32x16 mfma(bf16x8 a, bf16x8 b, f32x16 c) { return __builtin_amdgcn_mfma_f32_32x32x16_bf16(a, b, c, 0, 0, 0); }
DI int crow(int i, int h) { return (i & 3) + 8 * (i >> 2) + 4 * h; }
DI bf16x8 pack8(const f32x16& x, int s) {
  u32x4 p;
  p[0] = pk2(x[8 * s + 0], x[8 * s + 1]); p[1] = pk2(x[8 * s + 2], x[8 * s + 3]);
  p[2] = pk2(x[8 * s + 4], x[8 * s + 5]); p[3] = pk2(x[8 * s + 6], x[8 * s + 7]);
  return __builtin_bit_cast(bf16x8, p);
}
DI float silu_f(float v) { return v * __frcp_rn(1.f + __expf(-v)); }
DI float sigmoid_f(float v) { return 1.f / (1.f + __expf(-v)); }
DI float logsigmoid_f(float v) { return fminf(v, 0.f) - log1pf(__expf(-fabsf(v))); }
DI int opaque_tid() { int t = threadIdx.x; asm volatile("" : "+v"(t)); return t; }
DI int vtid() { return opaque_tid() & (VT - 1); }
DI int vhalf() { return __builtin_amdgcn_readfirstlane(opaque_tid() >> 8); }
template <class T> DI T* opq(T* q) { asm volatile("" : "+s"(q)); return q; }
DI float logsigmoid_fast(float v) { return fminf(v, 0.f) - __logf(1.f + __expf(-fabsf(v))); }
DI float exp2_f(float v) { return __builtin_amdgcn_exp2f(v); }
DI f32x16 zero16() { f32x16 z; for (int i = 0; i < 16; ++i) z[i] = 0.f; return z; }


#define XB_TMO      128
#define XB_XCNT(j)  (256  + 64 * (j))
#define XB_XSUB(j)  (1280 + 64 * (j))
#define XB_XGEN(j)  (2304 + 64 * (j))
#define XB_TOP      3328
#define XB_TOPGEN   3392
#define XB_CTR      3456
#define XB_CMPCNT   3520
#define XCD_BAR_WORDS 3584
#define XB_SPIN_CAP (1u << 20)
DI unsigned xb_ld(unsigned* q) { return __hip_atomic_load(q, __ATOMIC_RELAXED, __HIP_MEMORY_SCOPE_AGENT); }
DI unsigned xb_add(unsigned* q, unsigned v) { return __hip_atomic_fetch_add(q, v, __ATOMIC_RELAXED, __HIP_MEMORY_SCOPE_AGENT); }
DI unsigned xb_xcc_id() { return (unsigned)__builtin_amdgcn_s_getreg((3 << 11) | 20) & 0xFu; }
#define XB_SPIN(cond, bar) do { unsigned _sp = 0; while (cond) { __builtin_amdgcn_s_sleep(1); \
    if ((++_sp & 255u) == 0u) { if (xb_ld(&(bar)[XB_TMO])) break; if (_sp > XB_SPIN_CAP) { atomicAdd(&(bar)[XB_TMO], 1u); break; } } } } while (0)
DI void xcd_barrier_complete(unsigned* bar, unsigned x, unsigned& nloc, unsigned& nx) {
  const unsigned G = gridDim.x;
  unsigned sum, cnt, mine, sp = 0u;
  for (;;) {
    sum = 0u; cnt = 0u; mine = 0u;
#pragma unroll
    for (unsigned j = 0; j < 16; ++j) { const unsigned c = xb_ld(&bar[XB_XCNT(j)]); sum += c; cnt += (c > 0u) ? 1u : 0u; mine = (j == x) ? c : mine; }
    if (sum == G) break;
    __builtin_amdgcn_s_sleep(1);
    if ((++sp & 255u) == 0u) { if (xb_ld(&bar[XB_TMO])) break; if (sp > XB_SPIN_CAP) { atomicAdd(&bar[XB_TMO], 1u); break; } }
  }
  nloc = mine > 0u ? mine : 1u; nx = cnt > 0u ? cnt : 1u;
}
DI void xcd_barrier(unsigned* bar, unsigned x, volatile unsigned* st) {
  asm volatile("s_waitcnt vmcnt(0)" ::: "memory");
  __syncthreads();
  if (threadIdx.x == 0) {
    __builtin_amdgcn_s_waitcnt(0);
    unsigned nloc = st[0], nx = st[1];
    if (nloc == 0u) { xcd_barrier_complete(bar, x, nloc, nx); st[0] = nloc; st[1] = nx; }
    const unsigned old = xb_add(&bar[XB_XSUB(x)], 1u);
    const unsigned gen = old / nloc;
    if (old + 1u == (gen + 1u) * nloc) {
      __builtin_amdgcn_fence(__ATOMIC_RELEASE, "agent");
      asm volatile("s_waitcnt vmcnt(0)" ::: "memory");
      const unsigned og = xb_add(&bar[XB_TOP], 1u);
      const unsigned tg = og / nx;
      if (og + 1u == (tg + 1u) * nx) xb_add(&bar[XB_TOPGEN], 1u);
      else XB_SPIN(xb_ld(&bar[XB_TOPGEN]) == tg, bar);
      __builtin_amdgcn_fence(__ATOMIC_ACQUIRE, "agent");
      xb_add(&bar[XB_XGEN(x)], 1u);
      asm volatile("s_waitcnt vmcnt(0)" ::: "memory");
    } else {
      XB_SPIN(xb_ld(&bar[XB_XGEN(x)]) == gen, bar);
      __builtin_amdgcn_fence(__ATOMIC_ACQUIRE, "agent");
      asm volatile("s_waitcnt vmcnt(0)" ::: "memory");
    }
  }
  __syncthreads();
}

DI void hbar(unsigned* cnt) {
  asm volatile("s_waitcnt lgkmcnt(0)" ::: "memory");
  unsigned old = 0;
  if ((opaque_tid() & 63) == 0) old = __hip_atomic_fetch_add(cnt, 1u, __ATOMIC_RELAXED, __HIP_MEMORY_SCOPE_WORKGROUP);
  old = (unsigned)__builtin_amdgcn_readfirstlane((int)old);
  const unsigned target = (old / 4u + 1u) * 4u;
  while (__hip_atomic_load(cnt, __ATOMIC_RELAXED, __HIP_MEMORY_SCOPE_WORKGROUP) < target) __builtin_amdgcn_s_sleep(1);
  asm volatile("s_waitcnt lgkmcnt(0)" ::: "memory");
}

DI int ropeperm(int j) { return ((j >> 5) & 1) * 64 + (j >> 6) * 32 + (j & 31); }
DI int incol(int np) {
  const int tn = np >> 7, j = np & 127;
  if (tn < 16) return np;
  if (tn < 20) return 2048 + (tn - 16) * 128 + ropeperm(j);
  if (tn == 20) return 2560 + j;
  if (tn == 21) return 2688 + j;
  if (tn == 22) return 2816 + ropeperm(j);
  if (tn == 23) return 2944 + j;
  if (tn == 24) return 3072 + ropeperm(j);
  if (tn == 25) return 3200 + j;
  if (tn < 30) return 3340 + (tn - 26) * 128 + j;
  if (tn < 42) return 3852 + (tn - 30) * 128 + j;
  if (tn < 46) return 5392 + (tn - 42) * 128 + j;
  if (tn < 50) return 5904 + (tn - 46) * 128 + j;
  if (tn < 54) return 6480 + (tn - 50) * 128 + j;
  if (j < 64) return 6416 + j;
  if (j < 76) return 3328 + (j - 64);
  if (j < 80) return 5388 + (j - 76);
  return -1;
}
DI int colmap(int kind, int np) {
  if (kind == 0) return np;
  if (kind == 1) return incol(np);
  const int tn = np >> 7, j = np & 127;
  if (kind == 2) { if (tn < 4) return tn * 192 + j; const int hd = (tn - 4) * 2 + (j >> 6); return hd * 192 + 128 + (j & 63); }
  if (tn < 4) return tn * 256 + j;
  return (tn - 4) * 256 + 128 + j;
}

DI void tconv_out(const float* sT, u16* __restrict__ dst, int lddst, int k0, int n0);
DI void tconv(float* sT, const float* __restrict__ src, int ldsrc, u16* __restrict__ dst, int lddst, int k0, int n0, int kind, const float* __restrict__ gk) {
  const int tid = vtid();
  const int c4 = (tid & 15) * 4, rr = tid >> 4;
  const int sc = colmap(kind, n0 + c4);
  f32x4 v[4];
#pragma unroll
  for (int i = 0; i < 4; ++i) {
    const int k = rr + 16 * i;
    if (sc >= 0) v[i] = __builtin_nontemporal_load((const f32x4*)&src[(long)(k0 + k) * ldsrc + sc]);
    else { v[i][0] = 0.f; v[i][1] = 0.f; v[i][2] = 0.f; v[i][3] = 0.f; }
  }
#pragma unroll
  for (int i = 0; i < 4; ++i) {
    const int k = rr + 16 * i;
    const float g = gk ? gk[k0 + k] : 1.f;
    sT[k * 65 + c4 + 0] = v[i][0] * g; sT[k * 65 + c4 + 1] = v[i][1] * g; sT[k * 65 + c4 + 2] = v[i][2] * g; sT[k * 65 + c4 + 3] = v[i][3] * g;
  }
  __syncthreads();
  tconv_out(sT, dst, lddst, k0, n0);
  __syncthreads();
}

DI void tconv_load(f32x4 (&v)[4], const float* __restrict__ src, int ldsrc, int k0, int n0, int kind) {
  const int tid = vtid();
  const int c4 = (tid & 15) * 4, rr = tid >> 4;
  const int sc = colmap(kind, n0 + c4);
#pragma unroll
  for (int i = 0; i < 4; ++i) {
    const int k = rr + 16 * i;
    if (sc >= 0) v[i] = __builtin_nontemporal_load((const f32x4*)&src[(long)(k0 + k) * ldsrc + sc]);
    else { v[i][0] = 0.f; v[i][1] = 0.f; v[i][2] = 0.f; v[i][3] = 0.f; }
  }
}
DI void tconv_lds(float* sT, const f32x4 (&v)[4]) {
  const int tid = vtid();
  const int c4 = (tid & 15) * 4, rr = tid >> 4;
#pragma unroll
  for (int i = 0; i < 4; ++i) {
    const int k = rr + 16 * i;
    sT[k * 65 + c4 + 0] = v[i][0]; sT[k * 65 + c4 + 1] = v[i][1]; sT[k * 65 + c4 + 2] = v[i][2]; sT[k * 65 + c4 + 3] = v[i][3];
  }
}
DI void tconv_out(const float* sT, u16* __restrict__ dst, int lddst, int k0, int n0) {
  const int tid = vtid();
  const int kc = (tid & 7) * 8, n = tid >> 3;
#pragma unroll
  for (int i = 0; i < 2; ++i) {
    const int nn = n + 32 * i;
    u32x4 o;
    o[0] = pk2(sT[(kc + 0) * 65 + nn], sT[(kc + 1) * 65 + nn]); o[1] = pk2(sT[(kc + 2) * 65 + nn], sT[(kc + 3) * 65 + nn]);
    o[2] = pk2(sT[(kc + 4) * 65 + nn], sT[(kc + 5) * 65 + nn]); o[3] = pk2(sT[(kc + 6) * 65 + nn], sT[(kc + 7) * 65 + nn]);
    *(u32x4*)&dst[(long)(n0 + nn) * lddst + k0 + kc] = o;
  }
}
DI void bigw_desc(const P& p, int it, const float*& src, int& ldsrc, u16*& dst, int& k0, int& n0, int& kind) {
  if (it < 7040) {
    const int l = it / 3520, r = it % 3520; const int nt = r >> 5, kt = r & 31;
    src = p.w_in + (long)l * D_ * NINO; ldsrc = NINO; dst = ((u16*)(p.ws + OFF_wt_in)) + (long)l * NINP * D_; k0 = kt * 64; n0 = nt * 64; kind = 1;
  } else {
    const int i2 = it - 7040; const int l = i2 >> 10, r = i2 & 1023; const int nt = r >> 5, kt = r & 31;
    src = p.w_out + (long)l * D_ * D_; ldsrc = D_; dst = ((u16*)(p.ws + OFF_wt_out)) + (long)l * D_ * D_; k0 = kt * 64; n0 = nt * 64; kind = 0;
  }
}

DI void norm_row(const P& p, int row, int mode, const float* __restrict__ xprev, const u16* __restrict__ y, const float* __restrict__ postg,
                 float* __restrict__ xout, const float* __restrict__ preg, u16* __restrict__ hout) {
  const int lane = vtid() & 63;
  f32x4 xv[8];
  const long base = (long)row * D_;
#pragma unroll
  for (int j = 0; j < 8; ++j) xv[j] = *(const f32x4*)&xprev[base + (j * 64 + lane) * 4];
  if (mode == 1) {
    f32x4 yv[8];
    float ss = 0.f;
#pragma unroll
    for (int j = 0; j < 8; ++j) { const u32x2 yb = *(const u32x2*)&y[base + (j * 64 + lane) * 4]; yv[j][0] = __uint_as_float(yb[0] << 16); yv[j][1] = __uint_as_float(yb[0] & 0xffff0000u); yv[j][2] = __uint_as_float(yb[1] << 16); yv[j][3] = __uint_as_float(yb[1] & 0xffff0000u); ss += yv[j][0] * yv[j][0] + yv[j][1] * yv[j][1] + yv[j][2] * yv[j][2] + yv[j][3] * yv[j][3]; }
#pragma unroll
    for (int o = 32; o > 0; o >>= 1) ss += __shfl_xor(ss, o);
    const float rs = rsqrtf(ss * (1.f / D_) + 1e-6f);
#pragma unroll
    for (int j = 0; j < 8; ++j) {
      const f32x4 g = *(const f32x4*)&postg[(j * 64 + lane) * 4];
      xv[j][0] += yv[j][0] * rs * g[0]; xv[j][1] += yv[j][1] * rs * g[1]; xv[j][2] += yv[j][2] * rs * g[2]; xv[j][3] += yv[j][3] * rs * g[3];
      *(f32x4*)&xout[base + (j * 64 + lane) * 4] = xv[j];
    }
  }
  if (preg) {
    float ss = 0.f;
#pragma unroll
    for (int j = 0; j < 8; ++j) ss += xv[j][0] * xv[j][0] + xv[j][1] * xv[j][1] + xv[j][2] * xv[j][2] + xv[j][3] * xv[j][3];
#pragma unroll
    for (int o = 32; o > 0; o >>= 1) ss += __shfl_xor(ss, o);
    const float rs = rsqrtf(ss * (1.f / D_) + 1e-6f);
#pragma unroll
    for (int j = 0; j < 8; ++j) {
      const f32x4 g = *(const f32x4*)&preg[(j * 64 + lane) * 4];
      u32x2 o2; o2[0] = pk2(xv[j][0] * rs * g[0], xv[j][1] * rs * g[1]); o2[1] = pk2(xv[j][2] * rs * g[2], xv[j][3] * rs * g[3]);
      *(u32x2*)&hout[base + (j * 64 + lane) * 4] = o2;
    }
  }
}

DI void phase0(const P& p, char* smem) {
  const int half = vhalf();
  float* sT = (float*)(smem + half * HALF_BYTES);
  const int tid = vtid();
  const int vb = (int)blockIdx.x * 2 + half, vg = (int)gridDim.x * 2;
  constexpr int nA = 7040, nB = 2048, nC = 512, nD = 16, nE = 144, nF = 64;
  constexpr int oB = nA, oC = oB + nB, oD = oC + nC, oE = oD + nD, oF = oE + nE, oG = oF + nF;
  constexpr int nG = 56, nH = 128, nI = 512, nK = 2048;
  constexpr int oH = oG + nG, oI = oH + nH, oK = oI + nI, total = oK + nK;
  {
    int it = vb;
    f32x4 v[4];
    const float* src; int ldsrc; u16* dst; int k0, n0, kind;
    if (it < oC) { bigw_desc(p, it, src, ldsrc, dst, k0, n0, kind); tconv_load(v, src, ldsrc, k0, n0, kind); }
    while (it < oC) {
      tconv_lds(sT, v);
      __syncthreads();
      const int nxt = it + vg;
      const float* src2 = src; int ldsrc2 = ldsrc; u16* dst2 = dst; int k02 = k0, n02 = n0, kind2 = kind;
      if (nxt < oC) { bigw_desc(p, nxt, src2, ldsrc2, dst2, k02, n02, kind2); tconv_load(v, src2, ldsrc2, k02, n02, kind2); }
      tconv_out(sT, dst, D_, k0, n0);
      __syncthreads();
      it = nxt; src = src2; ldsrc = ldsrc2; dst = dst2; k0 = k02; n0 = n02; kind = kind2;
    }
  }
  for (int it = oC + vb; it < total; it += vg) {
    if (it < oB) {
      const int l = it / 3520, r = it % 3520; const int nt = r >> 5, kt = r & 31;
      tconv(sT, p.w_in + (long)l * D_ * NINO, NINO, ((u16*)(p.ws + OFF_wt_in)) + (long)l * NINP * D_, D_, kt * 64, nt * 64, 1, nullptr);
    } else if (it < oC) {
      const int i2 = it - oB; const int l = i2 >> 10, r = i2 & 1023; const int nt = r >> 5, kt = r & 31;
      tconv(sT, p.w_out + (long)l * D_ * D_, D_, ((u16*)(p.ws + OFF_wt_out)) + (long)l * D_ * D_, D_, kt * 64, nt * 64, 0, nullptr);
    } else if (it < oD) {
      const int i2 = it - oC; const int ls = i2 >> 7, r = i2 & 127; const int nt = r >> 6, kt = r & 63;
      const float* src = ((ls & 1) ? p.w1_v : p.w1_k) + (long)(ls >> 1) * 4096 * 128;
      tconv(sT, src, 128, ((u16*)(p.ws + OFF_w1t)) + (long)ls * 128 * 4096, 4096, kt * 64, nt * 64, 0, nullptr);
    } else if (it < oE) {
      const int i2 = it - oD; const int ls = i2 >> 2, r = i2 & 3; const int nt = r >> 1, kt = r & 1;
      const float* src = ((ls & 1) ? p.w2_v : p.w2_k) + (long)(ls >> 1) * 128 * 128;
      tconv(sT, src, 128, ((u16*)(p.ws + OFF_w2t)) + (long)ls * 128 * 128, 128, kt * 64, nt * 64, 0, nullptr);
    } else if (it < oF) {
      const int i2 = it - oE; const int l = i2 / 72, r = i2 % 72; const int nt = r / 6, kt = r % 6;
      tconv(sT, p.w_uq + (long)l * 384 * 768, 768, ((u16*)(p.ws + OFF_wuqt)) + (long)l * 768 * 384, 384, kt * 64, nt * 64, 2, p.qn_g + l * 384);
    } else if (it < oG) {
      const int i2 = it - oF; const int l = i2 >> 5, r = i2 & 31; const int nt = r >> 1, kt = r & 1;
      tconv(sT, p.w_ukv + (long)l * 128 * 1024, 1024, ((u16*)(p.ws + OFF_wukvt)) + (long)l * 1024 * 128, 128, kt * 64, nt * 64, 3, p.kvn_g + l * 128);
    } else if (it < oH) {
      const int i2 = it - oG;
      const int idx = i2 * 256 + tid;
      if (idx < 2 * NINP) { const int l = idx / NINP, np = idx % NINP; const int sc = incol(np); ((float*)(p.ws + OFF_bperm))[idx] = sc >= 0 ? p.b_in[l * NINO + sc] : 0.f; }
    } else if (it < oI) {
      const int i2 = it - oH; const int ls = i2 >> 5, c = i2 & 31;
      const float* w1 = ((ls & 1) ? p.w1_v : p.w1_k) + (long)(ls >> 1) * 4096 * 128;
      const float* pe = ((ls & 1) ? p.pos_v : p.pos_k) + (long)(ls >> 1) * 4096;
      const int n = tid & 127, hf = tid >> 7;
      float a = 0.f;
#pragma unroll 8
      for (int i = 0; i < 64; ++i) { const int k = c * 128 + hf * 64 + i; a += pe[k] * w1[(long)k * 128 + n]; }
      sT[tid] = a;
      __syncthreads();
      if (tid < 128) ((float*)(p.ws + OFF_c1part))[(ls * 32 + c) * 128 + tid] = sT[tid] + sT[tid + 128];
      __syncthreads();
    } else if (it < oK) {
      const int idx = (it - oI) * 256 + tid; const int pos = idx >> 6, f = idx & 63;
      const float inv = powf(10000.f, -(float)f / 64.f);
      const float ang = (float)pos * inv;
      float sn, cs; sincosf(ang, &sn, &cs);
      ((float*)(p.ws + OFF_ropec))[idx] = cs; ((float*)(p.ws + OFF_ropes))[idx] = sn;
    } else {
      const int row = (it - oK) * 4 + (tid >> 6);
      norm_row(p, row, 0, p.x, nullptr, nullptr, nullptr, p.pre_g, ((u16*)(p.ws + OFF_H)));
    }
  }
}

template <int WR, int WC, int RB, int CB, int GBK, int NT, class Epi>
DI void gemm_tile(char* smem, const u16* __restrict__ A, int lda, const u16* __restrict__ Bt, int ldb, int K, Epi epi) {
  constexpr int BM = WR * RB * 32, BN = WC * CB * 32;
  constexpr int GLD = GBK + 8;
  constexpr int CPR = GBK / 8;
  constexpr int RPP = NT / CPR;
  constexpr int NA = BM / RPP, NB = BN / RPP;
  constexpr bool DB = (NT == 512);
  constexpr int STAGE = (BM + BN) * GLD;
  u16* sbase = (u16*)smem;
  const int tid = opaque_tid() & (NT - 1), wave = tid >> 6, lane = tid & 63, r = lane & 31, h = lane >> 5;
  const int wr = wave / WC, wc = wave % WC;
  f32x16 acc[RB][CB];
#pragma unroll
  for (int i = 0; i < RB; ++i)
#pragma unroll
    for (int j = 0; j < CB; ++j) acc[i][j] = zero16();
  u32x4 ra[NA], rb[NB];
  const unsigned trow = (unsigned)tid / CPR, tcol = ((unsigned)tid % CPR) * 8;
  const unsigned voffA = (trow * (unsigned)lda + tcol) * 2u, voffB = (trow * (unsigned)ldb + tcol) * 2u;
  const unsigned soff = (trow * GLD + tcol) * 2u;
#pragma unroll
  for (int i = 0; i < NA; ++i) ra[i] = *(const u32x4*)((const char*)(A + (long)i * RPP * lda) + voffA);
#pragma unroll
  for (int i = 0; i < NB; ++i) rb[i] = *(const u32x4*)((const char*)(Bt + (long)i * RPP * ldb) + voffB);
  if (DB) {
    __syncthreads();
#pragma unroll
    for (int i = 0; i < NA; ++i) *(u32x4*)((char*)sbase + i * RPP * GLD * 2 + soff) = ra[i];
#pragma unroll
    for (int i = 0; i < NB; ++i) *(u32x4*)((char*)(sbase + BM * GLD) + i * RPP * GLD * 2 + soff) = rb[i];
    {
      const int k1 = GBK < K ? GBK : 0;
#pragma unroll
      for (int i = 0; i < NA; ++i) ra[i] = *(const u32x4*)((const char*)(A + (long)i * RPP * lda + k1) + voffA);
#pragma unroll
      for (int i = 0; i < NB; ++i) rb[i] = *(const u32x4*)((const char*)(Bt + (long)i * RPP * ldb + k1) + voffB);
    }
    __syncthreads();
  }
  int cur = 0;
  for (int k0 = 0; k0 < K; k0 += GBK) {
    u16* sA = sbase + (DB ? cur * STAGE : 0);
    u16* sB = sA + BM * GLD;
    u16* nA = sbase + (cur ^ 1) * STAGE;
    const int kn2 = (k0 + 2 * GBK < K) ? k0 + 2 * GBK : K - GBK;
    if (!DB) {
      __syncthreads();
#pragma unroll
      for (int i = 0; i < NA; ++i) *(u32x4*)((char*)sA + i * RPP * GLD * 2 + soff) = ra[i];
#pragma unroll
      for (int i = 0; i < NB; ++i) *(u32x4*)((char*)sB + i * RPP * GLD * 2 + soff) = rb[i];
      __syncthreads();
      if (k0 + GBK < K) {
#pragma unroll
        for (int i = 0; i < NA; ++i) ra[i] = *(const u32x4*)((const char*)(A + (long)i * RPP * lda + k0 + GBK) + voffA);
#pragma unroll
        for (int i = 0; i < NB; ++i) rb[i] = *(const u32x4*)((const char*)(Bt + (long)i * RPP * ldb + k0 + GBK) + voffB);
      }
    }
    {
      bf16x8 af[2][RB], bfr[2][CB];
#pragma unroll
      for (int i = 0; i < RB; ++i) af[0][i] = *(const bf16x8*)&sA[((wr * RB + i) * 32 + r) * GLD + h * 8];
#pragma unroll
      for (int j = 0; j < CB; ++j) bfr[0][j] = *(const bf16x8*)&sB[((wc * CB + j) * 32 + r) * GLD + h * 8];
#pragma unroll
      for (int ks = 0; ks < GBK / 16; ++ks) {
        if (ks + 1 < GBK / 16) {
#pragma unroll
          for (int i = 0; i < RB; ++i) af[(ks + 1) & 1][i] = *(const bf16x8*)&sA[((wr * RB + i) * 32 + r) * GLD + (ks + 1) * 16 + h * 8];
#pragma unroll
          for (int j = 0; j < CB; ++j) bfr[(ks + 1) & 1][j] = *(const bf16x8*)&sB[((wc * CB + j) * 32 + r) * GLD + (ks + 1) * 16 + h * 8];
        }
#pragma unroll
        for (int i = 0; i < RB; ++i)
#pragma unroll
          for (int j = 0; j < CB; ++j) acc[i][j] = mfma(af[ks & 1][i], bfr[ks & 1][j], acc[i][j]);
        if (DB) {
          if (ks < NA) { *(u32x4*)((char*)nA + ks * RPP * GLD * 2 + soff) = ra[ks]; ra[ks] = *(const u32x4*)((const char*)(A + (long)ks * RPP * lda + kn2) + voffA); }
          if (ks < NB) { *(u32x4*)((char*)(nA + BM * GLD) + ks * RPP * GLD * 2 + soff) = rb[ks]; rb[ks] = *(const u32x4*)((const char*)(Bt + (long)ks * RPP * ldb + kn2) + voffB); }
        }
        if (ks + 1 < GBK / 16) __builtin_amdgcn_sched_group_barrier(0x100, RB + CB, 0);
        __builtin_amdgcn_sched_group_barrier(0x008, RB * CB, 0);
      }
    }
    if (DB) { __syncthreads(); cur ^= 1; }
  }
  epi(acc, wr, wc, r, h);
}

DI void store_vt(const f32x16& a, u16* __restrict__ dst  ) {
#pragma unroll
  for (int s = 0; s < 2; ++s) {
    u32x4 v; v[0] = pk2(a[8 * s], a[8 * s + 1]); v[1] = pk2(a[8 * s + 2], a[8 * s + 3]); v[2] = pk2(a[8 * s + 4], a[8 * s + 5]); v[3] = pk2(a[8 * s + 6], a[8 * s + 7]);
    *(u32x4*)(dst + 16 * s) = v;
  }
}

template <int RB>
DI void g1_epilogue(const P& p, int layer, f32x16 (&acc)[RB][2], int m0, int tn, int cbase, int rowbase, int r, int h) {
  if (tn > 54) return;
  const float* bias = ((float*)(p.ws + OFF_bperm)) + layer * NINP + tn * 128 + cbase;
  const int b = m0 >> 11, sb0 = m0 & 2047;
#pragma unroll
  for (int jj = 0; jj < 2; ++jj) {
    const float bv = bias[jj * 32 + r];
#pragma unroll
    for (int i = 0; i < RB; ++i)
#pragma unroll
      for (int e = 0; e < 16; ++e) acc[i][jj][e] += bv;
  }
  int kind; u16* dst = nullptr; int ld = 0, coloff = 0; float scale = 1.f; int nh = 1, hd = 0;
  const float qs = 0.08838834764831845f * 1.4426950408889634f;
  if (tn < 4) { kind = 0; dst = ((u16*)(p.ws + OFF_SBQ)); ld = 512; coloff = tn * 128; scale = qs; }
  else if (tn < 8) { kind = 0; dst = ((u16*)(p.ws + OFF_SBK)); ld = 512; coloff = (tn - 4) * 128; }
  else if (tn < 12) { kind = 2; dst = ((u16*)(p.ws + OFF_SBVt)); nh = 4; hd = tn - 8; }
  else if (tn < 16) { kind = 3; coloff = (tn - 12) * 128; }
  else if (tn < 20) { kind = 1; dst = ((u16*)(p.ws + OFF_NQ)); ld = 512; coloff = (tn - 16) * 128; scale = qs; }
  else if (tn == 20) { kind = 0; dst = ((u16*)(p.ws + OFF_KCT)); ld = 128; }
  else if (tn == 21) { kind = 0; dst = ((u16*)(p.ws + OFF_VCT)); ld = 128; }
  else if (tn == 22) { kind = 1; dst = ((u16*)(p.ws + OFF_KSEL)); ld = 128; }
  else if (tn == 23) { kind = 2; dst = ((u16*)(p.ws + OFF_VSELt)); }
  else if (tn == 24) { kind = 1; dst = ((u16*)(p.ws + OFF_KWIN)); ld = 128; }
  else if (tn == 25) { kind = 2; dst = ((u16*)(p.ws + OFF_VWINt)); }
  else if (tn < 30) { kind = 3; coloff = 512 + (tn - 26) * 128; }
  else if (tn < 34) { kind = 0; dst = ((u16*)(p.ws + OFF_FQ)); ld = 512; coloff = (tn - 30) * 128; scale = qs; }
  else if (tn < 38) { kind = 0; dst = ((u16*)(p.ws + OFF_FK)); ld = 512; coloff = (tn - 34) * 128; }
  else if (tn < 42) { kind = 2; dst = ((u16*)(p.ws + OFF_FVt)); nh = 4; hd = tn - 38; }
  else if (tn < 46) { kind = 3; coloff = 1024 + (tn - 42) * 128; }
  else if (tn < 49) { kind = 0; dst = ((u16*)(p.ws + OFF_CQ)); ld = 384; coloff = (tn - 46) * 128; }
  else if (tn == 49) { kind = 0; dst = ((u16*)(p.ws + OFF_CKV)); ld = 128; }
  else if (tn < 54) { kind = 3; coloff = 1536 + (tn - 50) * 128; }
  else kind = 4;
  if (kind == 3) { kind = 0; dst = ((u16*)(p.ws + OFF_G)); ld = 2048; scale = 0.f; }
  if (kind == 0) {
#pragma unroll
    for (int i = 0; i < RB; ++i)
#pragma unroll
      for (int jj = 0; jj < 2; ++jj)
#pragma unroll
        for (int e = 0; e < 16; ++e) {
          const int m = m0 + rowbase + i * 32 + crow(e, h);
          const float v = acc[i][jj][e];
          dst[(long)m * ld + coloff + cbase + jj * 32 + r] = f2bf(scale == 0.f ? silu_f(v) : v * scale);
        }
  } else if (kind == 1) {
    const int f = (cbase >> 6) * 32 + r;
#pragma unroll
    for (int i = 0; i < RB; ++i)
#pragma unroll
      for (int e = 0; e < 16; ++e) {
        const int m = m0 + rowbase + i * 32 + crow(e, h);
        const int pos = m & 2047;
        const float cs = ((float*)(p.ws + OFF_ropec))[pos * 64 + f], sn = ((float*)(p.ws + OFF_ropes))[pos * 64 + f];
        const float x1 = acc[i][0][e], x2 = acc[i][1][e];
        dst[(long)m * ld + coloff + f] = f2bf((x1 * cs - x2 * sn) * scale);
        dst[(long)m * ld + coloff + 64 + f] = f2bf((x2 * cs + x1 * sn) * scale);
      }
  } else if (kind == 2) {
#pragma unroll
    for (int i = 0; i < RB; ++i)
#pragma unroll
      for (int jj = 0; jj < 2; ++jj) {
        const int d = cbase + jj * 32 + r;
        u16* o = dst + ((long)((b * nh + hd) * 128 + d)) * S_ + sb0 + rowbase + i * 32 + 8 * h;
        store_vt(acc[i][jj], o);
      }
  } else {
    const float* fbias = p.fb + layer * 4;
    if (cbase == 0) {
#pragma unroll
      for (int i = 0; i < RB; ++i)
#pragma unroll
        for (int e = 0; e < 16; ++e) {
          const int m = m0 + rowbase + i * 32 + crow(e, h);
          const int pos = m & 2047;
          const float cs = ((float*)(p.ws + OFF_ropec))[pos * 64 + 2 * r], sn = ((float*)(p.ws + OFF_ropes))[pos * 64 + 2 * r];
          const float x1 = acc[i][0][e], x2 = acc[i][1][e];
          ((u16*)(p.ws + OFF_KR))[(long)m * 64 + r] = f2bf(x1 * cs - x2 * sn);
          ((u16*)(p.ws + OFF_KR))[(long)m * 64 + 32 + r] = f2bf(x2 * cs + x1 * sn);
        }
    } else {
      if (r < 16) {
        const float fbv = r >= 12 ? fbias[r - 12] : 0.f;
#pragma unroll
        for (int i = 0; i < RB; ++i)
#pragma unroll
          for (int e = 0; e < 16; ++e) {
            const int m = m0 + rowbase + i * 32 + crow(e, h);
            const float v = acc[i][0][e];
            if (r < 12) ((float*)(p.ws + OFF_BR))[(long)m * 12 + r] = sigmoid_f(v);
            else ((float*)(p.ws + OFF_LOGF))[(long)m * 4 + (r - 12)] = logsigmoid_f(v + fbv);
          }
      }
    }
  }
}

DI void phase_g1(const P& p, int layer, char* smem) {
  const u16* Wt = ((u16*)(p.ws + OFF_wt_in)) + (long)layer * NINP * D_;
  constexpr int NBIG = 32 * 24, NSMALL = 32 * 7;
  for (int t = blockIdx.x; t < NBIG + NSMALL; t += gridDim.x) {
    if (t < NBIG) {
      const int xcd = t & 7, j = t >> 3;
      const int mt = xcd * 4 + (j & 3), tnb = j >> 2;
      const int m0 = mt * 256, n0 = tnb * 256;
      auto epi = [&](f32x16 (&acc)[4][2], int wr, int wc, int r, int h) { g1_epilogue<4>(p, layer, acc, m0, tnb * 2 + (wc >> 1), (wc & 1) * 64, wr * 128, r, h); };
      gemm_tile<2, 4, 4, 2, 64, 512>(smem, ((u16*)(p.ws + OFF_H)) + (long)m0 * D_, D_, Wt + (long)n0 * D_, D_, D_, epi);
    } else {
      const int t2 = t - NBIG;
      const int xcd = t2 & 7, j = t2 >> 3;
      const int mt = xcd * 4 + (j & 3), tn = 48 + (j >> 2);
      const int m0 = mt * 256, n0 = tn * 128;
      auto epi = [&](f32x16 (&acc)[2][2], int wr, int wc, int r, int h) { g1_epilogue<2>(p, layer, acc, m0, tn, wc * 64, wr * 64, r, h); };
      gemm_tile<4, 2, 2, 2, 64, 512>(smem, ((u16*)(p.ws + OFF_H)) + (long)m0 * D_, D_, Wt + (long)n0 * D_, D_, D_, epi);
    }
  }
}

DI void phase_prep(const P& p, int layer, char* smem) {
  float* sR = (float*)(smem + 2 * 512 * 72 * 2);
  constexpr int nCmp = 64, nCum = 8, nUQ = 32 * 3, nUKV = 32 * 4;
  int* sFlag = (int*)(smem + SH_OFF + 256);
  constexpr int oCum = nCmp, oUQ = oCum + nCum, oUKV = oUQ + nUQ, total = oUKV + nUKV;
  for (int it = blockIdx.x; it < total; it += gridDim.x) {
    const int tid = vtid(), half = vhalf();
    __syncthreads();
    if (it < oCum) {
      char* hs = smem + half * HALF_BYTES;
      const int kq = it & 3, grp = it >> 2;
      const int st = half, b = (grp >> 2) & 3, mt = grp & 3;
      const int ls = layer * 2 + st;
      const u16* tok = (st ? ((u16*)(p.ws + OFF_VCT)) : ((u16*)(p.ws + OFF_KCT))) + (long)b * S_ * 128;
      f32x16 hacc;
      auto epi1 = [&](f32x16 (&acc)[1][1], int wr, int wc, int r, int h) { hacc = acc[0][0]; };
      gemm_tile<1, 4, 1, 1, 128, 256>(hs, tok + (long)mt * 32 * 2048 + kq * 1024, 2048, ((u16*)(p.ws + OFF_w1t)) + (long)ls * 128 * 4096 + kq * 1024, 4096, 1024, epi1);
      {
        const int wave = tid >> 6, lane = tid & 63, r = lane & 31, h = lane >> 5;
        float* pgrp = ((float*)(p.ws + OFF_PART)) + (long)(grp * 2 + st) * 4 * 4096;
#pragma unroll
        for (int e = 0; e < 16; ++e) pgrp[kq * 4096 + crow(e, h) * 128 + wave * 32 + r] = hacc[e];
        asm volatile("s_waitcnt vmcnt(0)" ::: "memory");
        __syncthreads();
        if (opaque_tid() == 0) {
          __builtin_amdgcn_fence(__ATOMIC_RELEASE, "agent");
          asm volatile("s_waitcnt vmcnt(0)" ::: "memory");
          *sFlag = (int)xb_add(((unsigned*)(p.ws + OFF_ctr)) + XB_CMPCNT + layer * 16 + grp, 1u);
        }
        __syncthreads();
        if ((*sFlag & 3) != 3) continue;
        if (opaque_tid() == 0) {
          __builtin_amdgcn_fence(__ATOMIC_ACQUIRE, "agent");
          asm volatile("s_waitcnt vmcnt(0)" ::: "memory");
        }
        __syncthreads();
#pragma unroll
        for (int e = 0; e < 16; ++e) {
          const int o = crow(e, h) * 128 + wave * 32 + r;
          hacc[e] = (pgrp[o] + pgrp[4096 + o]) + (pgrp[2 * 4096 + o] + pgrp[3 * 4096 + o]);
        }
      }
      const int wave = tid >> 6, lane = tid & 63, r = lane & 31, h = lane >> 5;
      __syncthreads();
      u16* sH = (u16*)hs;
      float* sO = (float*)(hs + 16384);
      {
        const int col = wave * 32 + r;
        float c1 = 0.f;
        for (int c = 0; c < 32; ++c) c1 += ((float*)(p.ws + OFF_c1part))[(ls * 32 + c) * 128 + col];
#pragma unroll
        for (int e = 0; e < 16; ++e) sH[crow(e, h) * 136 + col] = f2bf(silu_f(hacc[e] + c1));
      }
      __syncthreads();
      {
        f32x16 o = zero16();
        const u16* w2 = ((u16*)(p.ws + OFF_w2t)) + (long)ls * 128 * 128;
#pragma unroll
        for (int ks = 0; ks < 8; ++ks) {
          const bf16x8 a = *(const bf16x8*)&sH[r * 136 + ks * 16 + h * 8];
          const bf16x8 bb = *(const bf16x8*)&w2[(wave * 32 + r) * 128 + ks * 16 + h * 8];
          o = mfma(a, bb, o);
        }
#pragma unroll
        for (int e = 0; e < 16; ++e) sO[crow(e, h) * 129 + wave * 32 + r] = o[e];
      }
      __syncthreads();
      if (st == 0) {
        for (int idx = tid; idx < 32 * 64; idx += VT) {
          const int row = idx >> 6, f = idx & 63; const int n = mt * 32 + row;
          float o1 = 0.f, o2 = 0.f;
          if (n < 127) {
            const int pos = 16 * n + 31;
            const float cs = ((float*)(p.ws + OFF_ropec))[pos * 64 + f], sn = ((float*)(p.ws + OFF_ropes))[pos * 64 + f];
            const float x1 = sO[row * 129 + f], x2 = sO[row * 129 + 64 + f];
            o1 = x1 * cs - x2 * sn; o2 = x2 * cs + x1 * sn;
          }
          ((u16*)(p.ws + OFF_KC))[((long)b * 128 + n) * 128 + f] = f2bf(o1);
          ((u16*)(p.ws + OFF_KC))[((long)b * 128 + n) * 128 + 64 + f] = f2bf(o2);
        }
      } else {
        for (int idx = tid; idx < 32 * 128; idx += VT) {
          const int d = idx >> 5, row = idx & 31; const int n = mt * 32 + row;
          const float v = n < 127 ? sO[row * 129 + d] : 0.f;
          const int m16 = n & 15; const int pp = (n & ~15) + 8 * ((m16 >> 2) & 1) + 4 * (m16 >> 3) + (m16 & 3);
          ((u16*)(p.ws + OFF_VCt))[((long)b * 128 + d) * 128 + pp] = f2bf(v);
        }
      }
    } else if (it < oUQ) {
      const int bh = (it - oCum) * 2 + half; const int b = bh >> 2, hh = bh & 3;
      if (tid < 64) {
        const float* lf = ((float*)(p.ws + OFF_LOGF)) + (long)b * S_ * 4 + hh;
        float v[32]; float run = 0.f;
#pragma unroll
        for (int i = 0; i < 32; ++i) { run += lf[(long)(tid * 32 + i) * 4]; v[i] = run; }
        float inc = run;
#pragma unroll
        for (int o = 1; o < 64; o <<= 1) { const float t2 = __shfl_up(inc, o); if (tid >= o) inc += t2; }
        const float excl = inc - run;
#pragma unroll
        for (int i = 0; i < 32; ++i) ((float*)(p.ws + OFF_CUM))[(long)bh * S_ + tid * 32 + i] = (v[i] + excl) * 1.4426950408889634f;
      }
    } else {
      const int rt = opaque_tid();
      const bool isq = it < oUKV;
      const int i2 = isq ? it - oUQ : it - oUKV;
      const int ntn = isq ? 3 : 4;
      const int mt = i2 / ntn, tnb = i2 % ntn;
      const int m0 = mt * 256, n0 = tnb * 256;
      const int K = isq ? 384 : 128;
      const u16* A = (isq ? ((u16*)(p.ws + OFF_CQ)) : ((u16*)(p.ws + OFF_CKV))) + (long)m0 * K;
      {
        const int row = rt >> 1, hf = rt & 1;
        const u16* ar = A + (long)row * K + hf * (K / 2);
        float ss = 0.f;
#pragma unroll 8
        for (int c = 0; c < K / 16; ++c) {
          const u32x4 v = *(const u32x4*)(ar + c * 8);
#pragma unroll
          for (int q = 0; q < 4; ++q) { const float lo = __uint_as_float(v[q] << 16), hi = __uint_as_float(v[q] & 0xffff0000u); ss += lo * lo + hi * hi; }
        }
        ss += __shfl_xor(ss, 1);
        if (hf == 0) sR[row] = rsqrtf(ss / (float)K + 1e-6f);
      }
      const u16* Bt = (isq ? ((u16*)(p.ws + OFF_wuqt)) + (long)layer * 768 * 384 : ((u16*)(p.ws + OFF_wukvt)) + (long)layer * 1024 * 128) + (long)n0 * K;
      auto epi = [&](f32x16 (&acc)[4][2], int wr, int wc, int r, int h) {
        const int b = m0 >> 11, sb0 = m0 & 2047;
        const int tn = tnb * 2 + (wc >> 1), cb = (wc & 1) * 64, rb0 = wr * 128;
        const float qs = 0.07216878364870322f * 1.4426950408889634f;
        if (isq) {
          if (tn < 4) {
#pragma unroll
            for (int i = 0; i < 4; ++i)
#pragma unroll
              for (int jj = 0; jj < 2; ++jj)
#pragma unroll
                for (int e = 0; e < 16; ++e) {
                  const int ml = rb0 + i * 32 + crow(e, h);
                  ((u16*)(p.ws + OFF_MQ))[(long)(m0 + ml) * 768 + tn * 192 + cb + jj * 32 + r] = f2bf(acc[i][jj][e] * sR[ml] * qs);
                }
          } else {
            const int hd = (tn - 4) * 2 + (wc & 1);
#pragma unroll
            for (int i = 0; i < 4; ++i)
#pragma unroll
              for (int e = 0; e < 16; ++e) {
                const int ml = rb0 + i * 32 + crow(e, h);
                const int pos = (m0 + ml) & 2047;
                const float cs = ((float*)(p.ws + OFF_ropec))[pos * 64 + 2 * r], sn = ((float*)(p.ws + OFF_ropes))[pos * 64 + 2 * r];
                const float sc = sR[ml] * qs;
                const float x1 = acc[i][0][e] * sc, x2 = acc[i][1][e] * sc;
                ((u16*)(p.ws + OFF_MQ))[(long)(m0 + ml) * 768 + hd * 192 + 128 + r] = f2bf(x1 * cs - x2 * sn);
                ((u16*)(p.ws + OFF_MQ))[(long)(m0 + ml) * 768 + hd * 192 + 160 + r] = f2bf(x2 * cs + x1 * sn);
              }
          }
        } else {
          if (tn < 4) {
#pragma unroll
            for (int i = 0; i < 4; ++i)
#pragma unroll
              for (int jj = 0; jj < 2; ++jj)
#pragma unroll
                for (int e = 0; e < 16; ++e) {
                  const int ml = rb0 + i * 32 + crow(e, h);
                  ((u16*)(p.ws + OFF_MKN))[(long)(m0 + ml) * 512 + tn * 128 + cb + jj * 32 + r] = f2bf(acc[i][jj][e] * sR[ml]);
                }
          } else {
            const int hd = tn - 4;
#pragma unroll
            for (int i = 0; i < 4; ++i)
#pragma unroll
              for (int jj = 0; jj < 2; ++jj) {
                f32x16 a = acc[i][jj];
#pragma unroll
                for (int e = 0; e < 16; ++e) a[e] *= sR[rb0 + i * 32 + crow(e, h)];
                const int d = cb + jj * 32 + r;
                u16* o = ((u16*)(p.ws + OFF_MVt)) + ((long)((b * 4 + hd) * 128 + d)) * S_ + sb0 + rb0 + i * 32 + 8 * h;
                store_vt(a, o);
              }
          }
        }
      };
      gemm_tile<2, 4, 4, 2, 64, 512>(smem, A, K, Bt, K, K, epi);
    }
  }
}

template <int NSTEP, int KLD>
DI void qk_tile(const u16* sK, const bf16x8 (&qf)[NSTEP], f32x16& s0, f32x16& s1, int r, int h) {
  s0 = zero16(); s1 = zero16();
#pragma unroll
  for (int st = 0; st < NSTEP; ++st) {
    const bf16x8 a0 = *(const bf16x8*)&sK[r * KLD + st * 16 + h * 8];
    const bf16x8 a1 = *(const bf16x8*)&sK[(32 + r) * KLD + st * 16 + h * 8];
    s0 = mfma(a0, qf[st], s0);
    s1 = mfma(a1, qf[st], s1);
  }
}
DI void pv_tile(const u16* sV, const f32x16& p0, const f32x16& p1, f32x16 (&o)[4], int r, int h) {
#pragma unroll
  for (int kb = 0; kb < 2; ++kb)
#pragma unroll
    for (int s = 0; s < 2; ++s) {
      const bf16x8 pb = pack8(kb ? p1 : p0, s);
#pragma unroll
      for (int db = 0; db < 4; ++db) {
        const bf16x8 a = *(const bf16x8*)&sV[(db * 32 + r) * VLD + kb * 32 + s * 16 + h * 8];
        o[db] = mfma(a, pb, o[db]);
      }
    }
}
DI void softmax_step(f32x16& s0, f32x16& s1, float& m, float& l, f32x16 (&o)[4]) {
  float tm = -INFINITY;
#pragma unroll
  for (int i = 0; i < 16; ++i) tm = fmaxf(tm, fmaxf(s0[i], s1[i]));
  tm = fmaxf(tm, __shfl_xor(tm, 32));
  const float mn = fmaxf(m, tm);
  const float mu = (mn == -INFINITY) ? 0.f : mn;
  float ps = 0.f;
#pragma unroll
  for (int i = 0; i < 16; ++i) { s0[i] = exp2_f(s0[i] - mu); s1[i] = exp2_f(s1[i] - mu); ps += s0[i] + s1[i]; }
  if (__any(mn != m)) {
    const float alpha = exp2_f(m - mu);
    l *= alpha;
#pragma unroll
    for (int db = 0; db < 4; ++db)
#pragma unroll
      for (int i = 0; i < 16; ++i) o[db][i] *= alpha;
  }
  l += ps;
  m = mn;
}

template <int NCH>
struct KStage { u32x4 v[NCH / 4]; };
template <int NCH>
DI void k_fetch(KStage<NCH>& st, const u16* __restrict__ k1, long ld1, const u16* __restrict__ k2, long ld2) {
  const int tid = vtid();
#pragma unroll
  for (int i = 0; i < NCH / 4; ++i) {
    const int c = tid + VT * i; const int row = c / NCH, ch = c % NCH;
    const u16* src = (NCH > 16 && ch >= 16) ? (k2 + (unsigned)(row * (int)ld2 + (ch - 16) * 8)) : (k1 + (unsigned)(row * (int)ld1 + ch * 8));
    st.v[i] = *(const u32x4*)src;
  }
}
template <int NCH, int KLD>
DI void k_commit(const KStage<NCH>& st, u16* sK) {
  const int tid = vtid();
#pragma unroll
  for (int i = 0; i < NCH / 4; ++i) {
    const int c = tid + VT * i; const int row = c / NCH, ch = c % NCH;
    *(u32x4*)&sK[row * KLD + ch * 8] = st.v[i];
  }
}
struct VStage { u32x4 v[4]; };
DI void v_fetch(VStage& st, const u16* __restrict__ vt, long ldv) {
  const int tid = vtid();
#pragma unroll
  for (int i = 0; i < 4; ++i) { const int c = tid + VT * i; st.v[i] = *(const u32x4*)(vt + (unsigned)((c >> 3) * (int)ldv + (c & 7) * 8)); }
}
DI void v_commit(const VStage& st, u16* sV) {
  const int tid = vtid();
#pragma unroll
  for (int i = 0; i < 4; ++i) { const int c = tid + VT * i; *(u32x4*)&sV[(c >> 3) * VLD + (c & 7) * 8] = st.v[i]; }
}

DI void store_mix(const P& p, const f32x16 (&o)[4], float rowscale, int t, int col0, int h) {
  asm volatile("" : "+v"(t));
  const long base = (long)t * 2048 + col0 + 4 * h;
  const u16* gp = ((u16*)(p.ws + OFF_G)) + base;
  u16* mp = ((u16*)(p.ws + OFF_MIX)) + base;
#pragma unroll
  for (int db = 0; db < 4; ++db)
#pragma unroll
    for (int g = 0; g < 4; ++g) {
      const int d = db * 32 + 8 * g;
      const u32x2 gv = *(const u32x2*)&gp[d];
      const float g0 = __uint_as_float(gv[0] << 16), g1 = __uint_as_float(gv[0] & 0xffff0000u);
      const float g2 = __uint_as_float(gv[1] << 16), g3 = __uint_as_float(gv[1] & 0xffff0000u);
      u32x2 ov;
      ov[0] = pk2(o[db][4 * g] * rowscale * g0, o[db][4 * g + 1] * rowscale * g1);
      ov[1] = pk2(o[db][4 * g + 2] * rowscale * g2, o[db][4 * g + 3] * rowscale * g3);
      *(u32x2*)&mp[d] = ov;
    }
}

template <int TYPE>
DI void attn_causal_item(const P& p, int bh, int qb, char* smem) {
  unsigned* hbc = (unsigned*)(smem + AOFF_HB);
  constexpr int NSTEP = TYPE == 2 ? 12 : 8;
  constexpr int NCH = TYPE == 2 ? 24 : 16;
  constexpr int KLD = TYPE == 2 ? 200 : 136;
  constexpr bool DBUF = TYPE != 2;
  u16* sK = (u16*)smem;
  u16* sV = (u16*)(smem + AOFF_V0);
  float* sC = (float*)(smem + AOFF_C);
  volatile int* sDone = (volatile int*)(smem + AOFF_DONE);
  const int tid = vtid(), wave = tid >> 6, lane = tid & 63, r = lane & 31, h = lane >> 5;
  const int b = bh >> 2, hd = bh & 3;
  const int q0 = qb * 128;
  const int qpos = q0 + wave * 32 + r;
  const long tq = (long)b * S_ + qpos;
  const u16* Qp; const u16* K1; long ld1; const u16* K2 = nullptr; long ld2 = 0; const u16* Vt;
  int col0;
  if (TYPE == 0) { Qp = ((u16*)(p.ws + OFF_SBQ)) + tq * 512 + hd * 128; K1 = ((u16*)(p.ws + OFF_SBK)) + (long)b * S_ * 512 + hd * 128; ld1 = 512; Vt = ((u16*)(p.ws + OFF_SBVt)) + (long)bh * 128 * S_; col0 = hd * 128; }
  else if (TYPE == 1) { Qp = ((u16*)(p.ws + OFF_FQ)) + tq * 512 + hd * 128; K1 = ((u16*)(p.ws + OFF_FK)) + (long)b * S_ * 512 + hd * 128; ld1 = 512; Vt = ((u16*)(p.ws + OFF_FVt)) + (long)bh * 128 * S_; col0 = 1024 + hd * 128; }
  else { Qp = ((u16*)(p.ws + OFF_MQ)) + tq * 768 + hd * 192; K1 = ((u16*)(p.ws + OFF_MKN)) + (long)b * S_ * 512 + hd * 128; ld1 = 512; K2 = ((u16*)(p.ws + OFF_KR)) + (long)b * S_ * 64; ld2 = 64; Vt = ((u16*)(p.ws + OFF_MVt)) + (long)bh * 128 * S_; col0 = 1536 + hd * 128; }
  bf16x8 qf[NSTEP];
#pragma unroll
  for (int st = 0; st < NSTEP; ++st) qf[st] = *(const bf16x8*)(Qp + st * 16 + h * 8);
  const float* cum = ((float*)(p.ws + OFF_CUM)) + (long)bh * S_;
  float cq = 0.f;
  if (TYPE == 1) cq = cum[qpos];
  f32x16 o[4];
#pragma unroll
  for (int db = 0; db < 4; ++db) o[db] = zero16();
  float m = -INFINITY, l = 0.f;
  float carry = 1.f;
  const int nt = 2 * qb + 2;
  KStage<NCH> ks; VStage vs; float cst = 0.f;
  {
    const int key0 = (nt - 1) * 64;
    k_fetch<NCH>(ks, K1 + (long)key0 * ld1, ld1, K2 + (long)key0 * ld2, ld2);
    v_fetch(vs, Vt + key0, S_);
    if (TYPE == 1 && tid < 64) cst = cum[key0 + tid];
  }
  const int qmax_w = q0 + wave * 32 + 31;
  if (TYPE == 0 && tid < 4) sDone[tid] = 0;
  if (DBUF) {
    hbar(hbc);
    k_commit<NCH, KLD>(ks, sK);
    v_commit(vs, sV);
    if (TYPE == 1 && tid < 64) sC[tid] = cst;
    if (nt > 1) {
      const int key0n = (nt - 2) * 64;
      k_fetch<NCH>(ks, K1 + (long)key0n * ld1, ld1, K2 + (long)key0n * ld2, ld2);
      v_fetch(vs, Vt + key0n, S_);
      if (TYPE == 1 && tid < 64) cst = cum[key0n + tid];
    }
    hbar(hbc);
    int cur = 0;
    for (int t = nt - 1; t >= 0; --t) {
      const int key0 = t * 64;
      const u16* sKc = (const u16*)(smem + cur * AOFF_K1); const u16* sVc = (const u16*)(smem + AOFF_V0 + cur * (AOFF_V1 - AOFF_V0)); const float* sCc = sC + cur * 64;
      u16* sKn = (u16*)(smem + (cur ^ 1) * AOFF_K1); u16* sVn = (u16*)(smem + AOFF_V0 + (cur ^ 1) * (AOFF_V1 - AOFF_V0));
      f32x16 s0, s1;
      qk_tile<NSTEP, KLD>(sKc, qf, s0, s1, r, h);
      if (t > 0) { k_commit<NCH, KLD>(ks, sKn); if (TYPE == 1 && tid < 64) sC[(cur ^ 1) * 64 + tid] = cst; }
      {
    if (TYPE == 0) {
#pragma unroll
        for (int i = 0; i < 16; ++i) {
          const int ka = key0 + crow(i, h), kb2 = ka + 32;
          const float f0 = __frcp_rn(1.f + exp2_f(fminf(s0[i], 115.f)));
          const float f1 = __frcp_rn(1.f + exp2_f(fminf(s1[i], 115.f)));
          s0[i] = (ka < qpos) ? f0 : 1.f;
          s1[i] = (kb2 < qpos) ? f1 : 1.f;
        }
        float gs[2][4], pg[2][4];
#pragma unroll
        for (int g = 0; g < 4; ++g) {
          gs[0][g] = (s0[4 * g] * s0[4 * g + 1]) * (s0[4 * g + 2] * s0[4 * g + 3]);
          gs[1][g] = (s1[4 * g] * s1[4 * g + 1]) * (s1[4 * g + 2] * s1[4 * g + 3]);
        }
#pragma unroll
        for (int kb = 0; kb < 2; ++kb)
#pragma unroll
          for (int g = 0; g < 4; ++g) pg[kb][g] = __shfl_xor(gs[kb][g], 32);
        float run = carry;
#pragma unroll
        for (int kb = 1; kb >= 0; --kb)
#pragma unroll
          for (int g = 3; g >= 0; --g) {
            const float after = run * (h == 0 ? pg[kb][g] : 1.f);
            f32x16& sx = kb ? s1 : s0;
            const float a3 = after, a2 = a3 * sx[4 * g + 3], a1 = a2 * sx[4 * g + 2], a0 = a1 * sx[4 * g + 1], am = a0 * sx[4 * g];
            sx[4 * g + 3] = a3 - a2; sx[4 * g + 2] = a2 - a1; sx[4 * g + 1] = a1 - a0; sx[4 * g] = a0 - am;
            run *= gs[kb][g] * pg[kb][g];
          }
        carry = run;
        if (__all(carry == 0.f) && lane == 0) sDone[wave] = 1;
      } else {
        if (TYPE == 1) {
#pragma unroll
          for (int i = 0; i < 16; ++i) { s0[i] += cq - sCc[crow(i, h)]; s1[i] += cq - sCc[32 + crow(i, h)]; }
        }
        if (key0 + 63 > q0 + wave * 32) {
#pragma unroll
          for (int i = 0; i < 16; ++i) {
            const int ka = key0 + crow(i, h), kb2 = ka + 32;
            s0[i] = ka <= qpos ? s0[i] : -INFINITY;
            s1[i] = kb2 <= qpos ? s1[i] : -INFINITY;
          }
        }
        softmax_step(s0, s1, m, l, o);
      }
      }
      if (t > 0) {
        v_commit(vs, sVn);
        if (t > 1) {
          const int key0n = (t - 2) * 64;
          k_fetch<NCH>(ks, K1 + (long)key0n * ld1, ld1, K2 + (long)key0n * ld2, ld2);
          v_fetch(vs, Vt + key0n, S_);
          if (TYPE == 1 && tid < 64) cst = cum[key0n + tid];
        }
      }
      pv_tile(sVc, s0, s1, o, r, h);
      hbar(hbc);
      cur ^= 1;
      if (TYPE == 0 && (sDone[0] & sDone[1] & sDone[2] & sDone[3])) break;
    }
  } else
  for (int t = nt - 1; t >= 0; --t) {
    hbar(hbc);
    if (TYPE == 0 && (sDone[0] & sDone[1] & sDone[2] & sDone[3])) break;
    k_commit<NCH, KLD>(ks, sK);
    v_commit(vs, sV);
    if (TYPE == 1 && tid < 64) sC[tid] = cst;
    hbar(hbc);
    if (t > 0) {
      const int key0n = (t - 1) * 64;
      k_fetch<NCH>(ks, K1 + (long)key0n * ld1, ld1, K2 + (long)key0n * ld2, ld2);
      v_fetch(vs, Vt + key0n, S_);
      if (TYPE == 1 && tid < 64) cst = cum[key0n + tid];
    }
    const int key0 = t * 64;
    if (key0 > qmax_w) continue;
    f32x16 s0, s1;
    qk_tile<NSTEP, KLD>(sK, qf, s0, s1, r, h);
    if (TYPE == 0) {
#pragma unroll
      for (int i = 0; i < 16; ++i) {
        const int ka = key0 + crow(i, h), kb2 = ka + 32;
        const float f0 = __frcp_rn(1.f + exp2_f(fminf(s0[i], 115.f)));
        const float f1 = __frcp_rn(1.f + exp2_f(fminf(s1[i], 115.f)));
        s0[i] = (ka < qpos) ? f0 : 1.f;
        s1[i] = (kb2 < qpos) ? f1 : 1.f;
      }
      float gs[2][4], pg[2][4];
#pragma unroll
      for (int g = 0; g < 4; ++g) {
        gs[0][g] = (s0[4 * g] * s0[4 * g + 1]) * (s0[4 * g + 2] * s0[4 * g + 3]);
        gs[1][g] = (s1[4 * g] * s1[4 * g + 1]) * (s1[4 * g + 2] * s1[4 * g + 3]);
      }
#pragma unroll
      for (int kb = 0; kb < 2; ++kb)
#pragma unroll
        for (int g = 0; g < 4; ++g) pg[kb][g] = __shfl_xor(gs[kb][g], 32);
      float run = carry;
#pragma unroll
      for (int kb = 1; kb >= 0; --kb)
#pragma unroll
        for (int g = 3; g >= 0; --g) {
          const float after = run * (h == 0 ? pg[kb][g] : 1.f);
          f32x16& sx = kb ? s1 : s0;
          const float a3 = after, a2 = a3 * sx[4 * g + 3], a1 = a2 * sx[4 * g + 2], a0 = a1 * sx[4 * g + 1], am = a0 * sx[4 * g];
          sx[4 * g + 3] = a3 - a2; sx[4 * g + 2] = a2 - a1; sx[4 * g + 1] = a1 - a0; sx[4 * g] = a0 - am;
          run *= gs[kb][g] * pg[kb][g];
        }
      carry = run;
      if (__all(carry == 0.f) && lane == 0) sDone[wave] = 1;
    } else {
      if (TYPE == 1) {
#pragma unroll
        for (int i = 0; i < 16; ++i) { s0[i] += cq - sC[crow(i, h)]; s1[i] += cq - sC[32 + crow(i, h)]; }
      }
      if (key0 + 63 > q0 + wave * 32) {
#pragma unroll
        for (int i = 0; i < 16; ++i) {
          const int ka = key0 + crow(i, h), kb2 = ka + 32;
          s0[i] = ka <= qpos ? s0[i] : -INFINITY;
          s1[i] = kb2 <= qpos ? s1[i] : -INFINITY;
        }
      }
      softmax_step(s0, s1, m, l, o);
    }
    pv_tile(sV, s0, s1, o, r, h);
  }
  float rowscale = 1.f;
  if (TYPE != 0) { const float lt = l + __shfl_xor(l, 32); rowscale = lt > 0.f ? 1.f / lt : 0.f; }
  store_mix(p, o, rowscale, (int)tq, col0, h);
}

DI void attn_nsa_item(const P& p, int b, int q0, char* smem) {
  unsigned* hbc = (unsigned*)(smem + AOFF_HB);
  u16* sK = (u16*)smem;
  u16* sV = (u16*)(smem + 25600);
  float* bufA = (float*)smem;
  float* bufB = bufA + 4 * 32 * 33;
  float* impF = bufB + 4 * 32 * 33;
  unsigned* qmask = (unsigned*)(smem + 25600 + 18432 + 256);
  constexpr int KLD = 136;
  const int tid = vtid(), wave = tid >> 6, lane = tid & 63, r = lane & 31, h = lane >> 5;
  const int qpos = q0 + r;
  const long tq = (long)b * S_ + qpos;
  const int cur = q0 >> 6;
  bf16x8 qf[8];
  {
    const u16* Qp = ((u16*)(p.ws + OFF_NQ)) + tq * 512 + wave * 128;
#pragma unroll
    for (int st = 0; st < 8; ++st) qf[st] = *(const bf16x8*)(Qp + st * 16 + h * 8);
  }
  const float gc = ((float*)(p.ws + OFF_BR))[tq * 12 + wave * 3 + 0], gsl = ((float*)(p.ws + OFF_BR))[tq * 12 + wave * 3 + 1], gw = ((float*)(p.ws + OFF_BR))[tq * 12 + wave * 3 + 2];
  float* Fp = ((float*)(p.ws + OFF_FN)) + tq * 512 + wave * 128;
  f32x16 o[4];
  KStage<16> ks; VStage vs;
  if (tid < 32) qmask[tid] = 0u;
  {
    const u16* KCb = ((u16*)(p.ws + OFF_KC)) + (long)b * 128 * 128;
    const u16* VCb = ((u16*)(p.ws + OFF_VCt)) + (long)b * 128 * 128;
    const bool two = q0 >= 1024;
    f32x16 sa0, sa1, sb0, sb1;
    k_fetch<16>(ks, KCb, 128, nullptr, 0);
    hbar(hbc);
    k_commit<16, KLD>(ks, sK);
    hbar(hbc);
    if (two) k_fetch<16>(ks, KCb + 64 * 128, 128, nullptr, 0);
    qk_tile<8, KLD>(sK, qf, sa0, sa1, r, h);
    if (two) {
      hbar(hbc);
      k_commit<16, KLD>(ks, sK);
      hbar(hbc);
      qk_tile<8, KLD>(sK, qf, sb0, sb1, r, h);
    } else {
#pragma unroll
      for (int i = 0; i < 16; ++i) { sb0[i] = -INFINITY; sb1[i] = -INFINITY; }
    }
    float tm = -INFINITY;
#pragma unroll
    for (int i = 0; i < 16; ++i) {
      const int n0 = crow(i, h);
      sa0[i] = (16 * n0 + 31 <= qpos) ? sa0[i] : -INFINITY;
      sa1[i] = (16 * (n0 + 32) + 31 <= qpos) ? sa1[i] : -INFINITY;
      sb0[i] = (16 * (n0 + 64) + 31 <= qpos) ? sb0[i] : -INFINITY;
      sb1[i] = ((n0 + 96) <= 126 && 16 * (n0 + 96) + 31 <= qpos) ? sb1[i] : -INFINITY;
      tm = fmaxf(tm, fmaxf(fmaxf(sa0[i], sa1[i]), fmaxf(sb0[i], sb1[i])));
    }
    tm = fmaxf(tm, __shfl_xor(tm, 32));
    const float mu = (tm == -INFINITY) ? 0.f : tm;
    float ps = 0.f;
#pragma unroll
    for (int i = 0; i < 16; ++i) {
      sa0[i] = exp2_f(sa0[i] - mu); sa1[i] = exp2_f(sa1[i] - mu); sb0[i] = exp2_f(sb0[i] - mu); sb1[i] = exp2_f(sb1[i] - mu);
      ps += (sa0[i] + sa1[i]) + (sb0[i] + sb1[i]);
    }
    ps += __shfl_xor(ps, 32);
    const float inv = ps > 0.f ? 1.f / ps : 0.f;
#pragma unroll
    for (int i = 0; i < 16; ++i) { sa0[i] *= inv; sa1[i] *= inv; sb0[i] *= inv; sb1[i] *= inv; }
    hbar(hbc);
#pragma unroll
    for (int tt = 0; tt < 2; ++tt)
#pragma unroll
      for (int kb = 0; kb < 2; ++kb) {
        const f32x16& pc = tt ? (kb ? sb1 : sb0) : (kb ? sa1 : sa0);
#pragma unroll
        for (int g = 0; g < 4; ++g) {
          const int s = 16 * tt + 8 * kb + 2 * g + h;
          bufA[(wave * 32 + r) * 33 + s] = (pc[4 * g] + pc[4 * g + 1]) + (pc[4 * g + 2] + 0.5f * pc[4 * g + 3]);
          if (s + 1 < 32) bufB[(wave * 32 + r) * 33 + s + 1] = 0.5f * pc[4 * g + 3];
        }
      }
    hbar(hbc);
    {
      const int q = tid >> 3, sub = tid & 7;
#pragma unroll
      for (int c = 0; c < 4; ++c) {
        const int s = sub * 4 + c;
        float a = 0.f;
#pragma unroll
        for (int w = 0; w < 4; ++w) a += bufA[(w * 32 + q) * 33 + s] + (s > 0 ? bufB[(w * 32 + q) * 33 + s] : 0.f);
        impF[q * 33 + s] = a;
      }
    }
    hbar(hbc);
    {
      const int q = tid >> 3, sub = tid & 7;
      unsigned bits = 0u;
      if (cur + 1 <= 16) {
        if (sub == 0) bits = (cur + 1 >= 32) ? 0xffffffffu : ((1u << (cur + 1)) - 1u);
      } else {
#pragma unroll
        for (int c = 0; c < 4; ++c) {
          const int s = sub * 4 + c;
          if (s > cur) continue;
          const bool forced = (s == 0) || (s == cur) || (s == cur - 1);
          if (forced) { bits |= 1u << s; continue; }
          const float v = impF[q * 33 + s];
          int rank = 0;
          for (int s2 = 1; s2 < cur - 1; ++s2) {
            const float v2 = impF[q * 33 + s2];
            rank += (v2 > v || (v2 == v && s2 < s)) ? 1 : 0;
          }
          if (rank < 13) bits |= 1u << s;
        }
      }
      if (bits) atomicOr(&qmask[q], bits);
    }
    hbar(hbc);
#pragma unroll
    for (int db = 0; db < 4; ++db) o[db] = zero16();
    v_fetch(vs, VCb, 128);
    v_commit(vs, sV);
    hbar(hbc);
    if (two) v_fetch(vs, VCb + 64, 128);
    pv_tile(sV, sa0, sa1, o, r, h);
    if (two) {
      hbar(hbc);
      v_commit(vs, sV);
      hbar(hbc);
      pv_tile(sV, sb0, sb1, o, r, h);
    }
#pragma unroll
    for (int db = 0; db < 4; ++db)
#pragma unroll
      for (int g = 0; g < 4; ++g) {
        f32x4 v; v[0] = o[db][4 * g] * gc; v[1] = o[db][4 * g + 1] * gc; v[2] = o[db][4 * g + 2] * gc; v[3] = o[db][4 * g + 3] * gc;
        *(f32x4*)&Fp[db * 32 + 8 * g + 4 * h] = v;
      }
  }
  const unsigned mybits = qmask[r];
  for (int br = 0; br < 2; ++br) {
    const u16* Kb = (br ? ((u16*)(p.ws + OFF_KWIN)) : ((u16*)(p.ws + OFF_KSEL))) + (long)b * S_ * 128;
    const u16* Vb = (br ? ((u16*)(p.ws + OFF_VWINt)) : ((u16*)(p.ws + OFF_VSELt))) + (long)b * 128 * S_;
    const int tlo = br ? ((q0 > 511 ? q0 - 511 : 0) >> 6) : 0;
    const int thi = cur;
#pragma unroll
    for (int db = 0; db < 4; ++db) o[db] = zero16();
    float m = -INFINITY, l = 0.f;
    k_fetch<16>(ks, Kb + (long)thi * 64 * 128, 128, nullptr, 0);
    v_fetch(vs, Vb + thi * 64, S_);
    hbar(hbc);
    k_commit<16, KLD>(ks, (u16*)smem);
    v_commit(vs, (u16*)(smem + AOFF_V0));
    if (thi > tlo) {
      k_fetch<16>(ks, Kb + (long)(thi - 1) * 64 * 128, 128, nullptr, 0);
      v_fetch(vs, Vb + (thi - 1) * 64, S_);
    }
    hbar(hbc);
    int cur = 0;
    for (int t = thi; t >= tlo; --t) {
      const u16* sKc = (const u16*)(smem + cur * AOFF_K1); const u16* sVc = (const u16*)(smem + AOFF_V0 + cur * (AOFF_V1 - AOFF_V0));
      u16* sKn = (u16*)(smem + (cur ^ 1) * AOFF_K1); u16* sVn = (u16*)(smem + AOFF_V0 + (cur ^ 1) * (AOFF_V1 - AOFF_V0));
      const int key0 = t * 64;
      f32x16 s0, s1;
      qk_tile<8, KLD>(sKc, qf, s0, s1, r, h);
      if (t > tlo) k_commit<16, KLD>(ks, sKn);
      const bool sel = br ? true : ((mybits >> t) & 1u);
      const bool interior = (key0 + 63 <= q0) && (br ? (key0 > q0 + 31 - 512) : (bool)__all(sel));
      if (!interior) {
#pragma unroll
        for (int i = 0; i < 16; ++i) {
          const int ka = key0 + crow(i, h), kb2 = ka + 32;
          bool v0 = sel && ka <= qpos, v1 = sel && kb2 <= qpos;
          if (br) { v0 = v0 && (ka > qpos - 512); v1 = v1 && (kb2 > qpos - 512); }
          s0[i] = v0 ? s0[i] : -INFINITY;
          s1[i] = v1 ? s1[i] : -INFINITY;
        }
      }
      softmax_step(s0, s1, m, l, o);
      if (t > tlo) {
        v_commit(vs, sVn);
        if (t - 1 > tlo) {
          k_fetch<16>(ks, Kb + (long)(t - 2) * 64 * 128, 128, nullptr, 0);
          v_fetch(vs, Vb + (t - 2) * 64, S_);
        }
      }
      pv_tile(sVc, s0, s1, o, r, h);
      hbar(hbc);
      cur ^= 1;
    }
    const float lt = l + __shfl_xor(l, 32);
    const float sc = (lt > 0.f ? 1.f / lt : 0.f) * (br ? gw : gsl);
    if (br == 0) {
#pragma unroll
      for (int db = 0; db < 4; ++db)
#pragma unroll
        for (int g = 0; g < 4; ++g) {
          f32x4 v = *(f32x4*)&Fp[db * 32 + 8 * g + 4 * h];
          v[0] += o[db][4 * g] * sc; v[1] += o[db][4 * g + 1] * sc; v[2] += o[db][4 * g + 2] * sc; v[3] += o[db][4 * g + 3] * sc;
          *(f32x4*)&Fp[db * 32 + 8 * g + 4 * h] = v;
        }
    } else {
#pragma unroll
      for (int db = 0; db < 4; ++db)
#pragma unroll
        for (int g = 0; g < 4; ++g) {
          const f32x4 v = *(f32x4*)&Fp[db * 32 + 8 * g + 4 * h];
          o[db][4 * g] = o[db][4 * g] * sc + v[0]; o[db][4 * g + 1] = o[db][4 * g + 1] * sc + v[1];
          o[db][4 * g + 2] = o[db][4 * g + 2] * sc + v[2]; o[db][4 * g + 3] = o[db][4 * g + 3] * sc + v[3];
        }
      store_mix(p, o, 1.f, (int)tq, 512 + wave * 128, h);
    }
  }
}

DI void phase_att(const P& p, int qidx, unsigned xcc, char* smem) {
  const int half = vhalf();
  char* hs = smem + half * HALF_BYTES;
  unsigned* hbc = (unsigned*)(hs + AOFF_HB);
  int* sItem = (int*)(hs + AOFF_ITEM);
  unsigned* ctr = ((unsigned*)(p.ws + OFF_ctr)) + XB_CTR + qidx * 8;
  __syncthreads();
  if (vtid() == 0) *hbc = 0u;
  __syncthreads();
  for (;;) {
    hbar(hbc);
    if (vtid() == 0) {
      int item = -1, qx = 0;
      for (int v = 0; v < 8; ++v) {
        const int xx = (int)((xcc + (unsigned)v) & 7u);
        if (xb_ld(&ctr[xx]) < 128u) {
          const unsigned got = atomicAdd(&ctr[xx], 1u);
          if (got < 128u) { item = (int)got; qx = xx; break; }
        }
      }
      sItem[0] = item; sItem[1] = qx;
    }
    hbar(hbc);
    const int li = sItem[0], x = sItem[1];
    if (li < 0) break;
    const int qb = 15 - (li >> 3), k = li & 7;
    if (k < 2) attn_causal_item<2>(p, 2 * x + k, qb, hs);
    else if (k < 4) attn_causal_item<1>(p, 2 * x + (k - 2), qb, hs);
    else if (k < 6) attn_causal_item<0>(p, 2 * x + (k - 4), qb, hs);
    else attn_nsa_item(p, x >> 1, qb * 128 + ((x & 1) * 2 + (k - 6)) * 32, hs);
  }
}

DI void phase_g2(const P& p, int layer, char* smem) {
  const u16* Wt = ((u16*)(p.ws + OFF_wt_out)) + (long)layer * D_ * D_;
  constexpr int TOT = 32 * 8;
  for (int t = blockIdx.x; t < TOT; t += gridDim.x) {
    const int xcd = t & 7, j = t >> 3;
    const int mt = xcd * 4 + (j & 3), tnb = j >> 2;
    const int m0 = mt * 256, n0 = tnb * 256;
    const u16* A = ((u16*)(p.ws + OFF_MIX)) + (long)m0 * D_;
    auto epi = [&](f32x16 (&acc)[4][2], int wr, int wc, int r, int h) {
#pragma unroll
      for (int i = 0; i < 4; ++i)
#pragma unroll
        for (int jj = 0; jj < 2; ++jj)
#pragma unroll
          for (int e = 0; e < 16; ++e) {
            const int m = m0 + wr * 128 + i * 32 + crow(e, h);
            ((u16*)(p.ws + OFF_Y))[(long)m * D_ + n0 + wc * 64 + jj * 32 + r] = f2bf(acc[i][jj][e]);
          }
    };
    gemm_tile<2, 4, 4, 2, 64, 512>(smem, A, D_, Wt + (long)n0 * D_, D_, D_, epi);
  }
}

DI void phase_norm(const P& p, int layer) {
  const int tid = vtid();
  const bool last = layer == 1;
  for (int it = blockIdx.x; it < T_ / 8; it += gridDim.x) {
    const int row = it * 8 + (opaque_tid() >> 6);
    norm_row(p, row, 1, layer == 0 ? p.x : ((float*)(p.ws + OFF_X1)), ((u16*)(p.ws + OFF_Y)), p.post_g + layer * D_, last ? p.out : ((float*)(p.ws + OFF_X1)),
             last ? nullptr : p.pre_g + (layer + 1) * D_, ((u16*)(p.ws + OFF_H)));
  }
}

__global__ void __launch_bounds__(NTHREADS, 2) hybrid_megakernel(P p) {
  __shared__ __attribute__((aligned(16))) char smem[SMEM_BYTES];
  __shared__ __attribute__((aligned(16))) unsigned xbst[4];
  unsigned* bar = (unsigned*)(p.ws + OFF_ctr);
  const unsigned xcc = xb_xcc_id();
  if (threadIdx.x == 0) { xbst[0] = 0u; xbst[1] = 0u; (void)xb_add(&bar[XB_XCNT(xcc)], 1u); }
  __syncthreads();
  for (int ph = p.phase_lo; ph < p.phase_hi; ++ph) {
    if (ph > p.phase_lo) {
      if (p.phase_lo < 0) cg::this_grid().sync();
      xcd_barrier(bar, xcc, xbst);
    }
    if (ph == 0) {
      phase0(p, smem);
#if DUP_SUB == 9
      xcd_barrier(bar, xcc, xbst); phase0(p, smem);
#endif
      continue;
    }
    const int layer = (ph - 1) / 5, sub = (ph - 1) % 5;
    for (int rep = 0; rep < (sub == DUP_SUB ? 2 : 1); ++rep) {
      if (rep) xcd_barrier(bar, xcc, xbst);
      if (sub == 0) phase_g1(p, layer, smem);
      else if (sub == 1) phase_prep(p, layer, smem);
      else if (sub == 2) phase_att(p, layer + 2 * rep, xcc, smem);
      else if (sub == 3) phase_g2(p, layer, smem);
      else phase_norm(p, layer);
    }
  }
}

extern "C" void kernel_launch(void* const* d_in, const int* in_sizes, int n_in, void* d_out, int out_size, void* d_ws, size_t ws_size,
                              hipStream_t stream) {
  static int grid_blocks = 0;
  if (!grid_blocks) {
    int dev = 0, cus = 0, per_cu = 0;
    hipGetDevice(&dev);
    hipDeviceGetAttribute(&cus, hipDeviceAttributeMultiprocessorCount, dev);
    hipOccupancyMaxActiveBlocksPerMultiprocessor(&per_cu, hybrid_megakernel, NTHREADS, 0);
    if (per_cu > 1) per_cu = 1;
    if (per_cu < 1) per_cu = 1;
    grid_blocks = cus * per_cu;
  }
  P p{};
  p.x = (const float*)d_in[0]; p.pre_g = (const float*)d_in[1]; p.post_g = (const float*)d_in[2]; p.w_in = (const float*)d_in[3];
  p.b_in = (const float*)d_in[4]; p.w_out = (const float*)d_in[5]; p.fb = (const float*)d_in[6]; p.pos_k = (const float*)d_in[7];
  p.w1_k = (const float*)d_in[8]; p.w2_k = (const float*)d_in[9]; p.pos_v = (const float*)d_in[10]; p.w1_v = (const float*)d_in[11];
  p.w2_v = (const float*)d_in[12]; p.qn_g = (const float*)d_in[13]; p.w_uq = (const float*)d_in[14]; p.kvn_g = (const float*)d_in[15];
  p.w_ukv = (const float*)d_in[16];
  p.out = (float*)d_out;
  p.ws = (char*)d_ws;
  p.phase_lo = 0; p.phase_hi = 11;
  hipMemsetAsync((char*)d_ws + OFF_ctr, 0, XCD_BAR_WORDS * sizeof(unsigned), stream);
  void* args[] = {&p};
  hipError_t e = hipLaunchCooperativeKernel((void*)hybrid_megakernel, dim3(grid_blocks), dim3(NTHREADS), args, 0, stream);
  if (e != hipSuccess) fprintf(stderr, "cooperative launch failed: %s (grid %d)\n", hipGetErrorString(e), grid_blocks);
}
```

```cpp
#include <hip/hip_runtime.h>
#include <hip/hip_cooperative_groups.h>
#include <cstdio>
namespace cg = cooperative_groups;

typedef unsigned short u16;
typedef short bf16x8 __attribute__((ext_vector_type(8)));
typedef float f32x16 __attribute__((ext_vector_type(16)));
typedef float f32x4 __attribute__((ext_vector_type(4)));
typedef float f32x2 __attribute__((ext_vector_type(2)));
typedef unsigned u32x4 __attribute__((ext_vector_type(4)));
typedef unsigned u32x2 __attribute__((ext_vector_type(2)));
typedef __bf16 bf16x2_t __attribute__((ext_vector_type(2)));

#define DI __device__ __forceinline__

constexpr int S_ = 2048;
constexpr int T_ = 8192;
constexpr int D_ = 2048;
constexpr int NINO = 6992;
constexpr int NINP = 7040;
constexpr int NTHREADS = 512;
constexpr int VT = 256;
constexpr int HALF_BYTES = 73728;
constexpr int AOFF_K1 = 17408, AOFF_V0 = 34816, AOFF_V1 = 53248, AOFF_C = 71680, AOFF_QM = 72192, AOFF_HB = 72448, AOFF_ITEM = 72512, AOFF_DONE = 72576;
constexpr int VLD = 72;
constexpr int SMEM_BYTES = 2 * 512 * 72 * 2 + 2048;
constexpr int SH_OFF = 2 * 512 * 72 * 2 + 1024;
#ifndef DUP_SUB
#define DUP_SUB -1
#endif

struct P {
  const float *x, *pre_g, *post_g, *w_in, *b_in, *w_out, *fb, *pos_k, *w1_k, *w2_k, *pos_v, *w1_v, *w2_v, *qn_g, *w_uq, *kvn_g, *w_ukv;
  float* out;
  char* ws;
  int phase_lo, phase_hi;
};
constexpr size_t OFF_wt_in = 0ull;
constexpr size_t OFF_wt_out = 57671680ull;
constexpr size_t OFF_w1t = 74448896ull;
constexpr size_t OFF_w2t = 78643200ull;
constexpr size_t OFF_wuqt = 78774272ull;
constexpr size_t OFF_wukvt = 79953920ull;
constexpr size_t OFF_c1part = 80478208ull;
constexpr size_t OFF_bperm = 80543744ull;
constexpr size_t OFF_ropec = 80600064ull;
constexpr size_t OFF_ropes = 81124352ull;
constexpr size_t OFF_H = 81648640ull;
constexpr size_t OFF_X1 = 115203072ull;
constexpr size_t OFF_Y = 182311936ull;
constexpr size_t OFF_SBQ = 249420800ull;
constexpr size_t OFF_SBK = 257809408ull;
constexpr size_t OFF_SBVt = 266198016ull;
constexpr size_t OFF_NQ = 274586624ull;
constexpr size_t OFF_KCT = 282975232ull;
constexpr size_t OFF_VCT = 285137920ull;
constexpr size_t OFF_KSEL = 287300608ull;
constexpr size_t OFF_VSELt = 289397760ull;
constexpr size_t OFF_KWIN = 291494912ull;
constexpr size_t OFF_VWINt = 293592064ull;
constexpr size_t OFF_FQ = 295689216ull;
constexpr size_t OFF_FK = 304077824ull;
constexpr size_t OFF_FVt = 312466432ull;
constexpr size_t OFF_CQ = 320855040ull;
constexpr size_t OFF_CKV = 327146496ull;
constexpr size_t OFF_KR = 329243648ull;
constexpr size_t OFF_G = 330292224ull;
constexpr size_t OFF_MQ = 363846656ull;
constexpr size_t OFF_MKN = 376429568ull;
constexpr size_t OFF_MVt = 384818176ull;
constexpr size_t OFF_KC = 393206784ull;
constexpr size_t OFF_VCt = 393337856ull;
constexpr size_t OFF_MIX = 393468928ull;
constexpr size_t OFF_BR = 427023360ull;
constexpr size_t OFF_LOGF = 427416576ull;
constexpr size_t OFF_CUM = 427547648ull;
constexpr size_t OFF_FN = 427678720ull;
constexpr size_t OFF_ctr = 444455936ull;
constexpr size_t OFF_PART = OFF_ctr + 65536;
constexpr size_t WS_TOTAL_OLD = 444456192ull;


DI unsigned pk2(float a, float b) { f32x2 v = {a, b}; bf16x2_t r = __builtin_convertvector(v, bf16x2_t); return __builtin_bit_cast(unsigned, r); }
DI u16 f2bf(float a) { return (u16)(pk2(a, 0.f) & 0xffffu); }
DI float bf2f(u16 v) { return __uint_as_float(((unsigned)v) << 16); }
DI f32x16 mfma(bf16x8 a, bf16x8 b, f32x16 c) { return __builtin_amdgcn_mfma_f32_32x32x16_bf16(a, b, c, 0, 0, 0); }
DI int crow(int i, int h) { return (i & 3) + 8 * (i >> 2) + 4 * h; }
DI bf16x8 pack8(const f32x16& x, int s) {
  u32x4 p;
  p[0] = pk2(x[8 * s + 0], x[8 * s + 1]); p[1] = pk2(x[8 * s + 2], x[8 * s + 3]);
  p[2] = pk2(x[8 * s + 4], x[8 * s + 5]); p[3] = pk2(x[8 * s + 6], x[8 * s + 7]);
  return __builtin_bit_cast(bf16x8, p);
}
DI float silu_f(float v) { return v * __frcp_rn(1.f + __expf(-v)); }
DI float sigmoid_f(float v) { return 1.f / (1.f + __expf(-v)); }
DI float logsigmoid_f(float v) { return fminf(v, 0.f) - log1pf(__expf(-fabsf(v))); }
DI int opaque_tid() { int t = threadIdx.x; asm volatile("" : "+v"(t)); return t; }
DI int vtid() { return opaque_tid() & (VT - 1); }
DI int vhalf() { return __builtin_amdgcn_readfirstlane(opaque_tid() >> 8); }
template <class T> DI T* opq(T* q) { asm volatile("" : "+s"(q)); return q; }
DI float logsigmoid_fast(float v) { return fminf(v, 0.f) - __logf(1.f + __expf(-fabsf(v))); }
DI float exp2_f(float v) { return __builtin_amdgcn_exp2f(v); }
DI f32x16 zero16() { f32x16 z; for (int i = 0; i < 16; ++i) z[i] = 0.f; return z; }


#define XB_TMO      128
#define XB_XCNT(j)  (256  + 64 * (j))
#define XB_XSUB(j)  (1280 + 64 * (j))
#define XB_XGEN(j)  (2304 + 64 * (j))
#define XB_TOP      3328
#define XB_TOPGEN   3392
#define XB_CTR      3456
#define XB_CMPCNT   3520
#define XCD_BAR_WORDS 3584
#define XB_SPIN_CAP (1u << 20)
DI unsigned xb_ld(unsigned* q) { return __hip_atomic_load(q, __ATOMIC_RELAXED, __HIP_MEMORY_SCOPE_AGENT); }
DI unsigned xb_add(unsigned* q, unsigned v) { return __hip_atomic_fetch_add(q, v, __ATOMIC_RELAXED, __HIP_MEMORY_SCOPE_AGENT); }
DI unsigned xb_xcc_id() { return (unsigned)__builtin_amdgcn_s_getreg((3 << 11) | 20) & 0xFu; }
#define XB_SPIN(cond, bar) do { unsigned _sp = 0; while (cond) { __builtin_amdgcn_s_sleep(1); \
    if ((++_sp & 255u) == 0u) { if (xb_ld(&(bar)[XB_TMO])) break; if (_sp > XB_SPIN_CAP) { atomicAdd(&(bar)[XB_TMO], 1u); break; } } } } while (0)
DI void xcd_barrier_complete(unsigned* bar, unsigned x, unsigned& nloc, unsigned& nx) {
  const unsigned G = gridDim.x;
  unsigned sum, cnt, mine, sp = 0u;
  for (;;) {
    sum = 0u; cnt = 0u; mine = 0u;
#pragma unroll
    for (unsigned j = 0; j < 16; ++j) { const unsigned c = xb_ld(&bar[XB_XCNT(j)]); sum += c; cnt += (c > 0u) ? 1u : 0u; mine = (j == x) ? c : mine; }
    if (sum == G) break;
    __builtin_amdgcn_s_sleep(1);
    if ((++sp & 255u) == 0u) { if (xb_ld(&bar[XB_TMO])) break; if (sp > XB_SPIN_CAP) { atomicAdd(&bar[XB_TMO], 1u); break; } }
  }
  nloc = mine > 0u ? mine : 1u; nx = cnt > 0u ? cnt : 1u;
}
DI void xcd_barrier(unsigned* bar, unsigned x, volatile unsigned* st) {
  asm volatile("s_waitcnt vmcnt(0)" ::: "memory");
  __syncthreads();
  if (threadIdx.x == 0) {
    __builtin_amdgcn_s_waitcnt(0);
    unsigned nloc = st[0], nx = st[1];
    if (nloc == 0u) { xcd_barrier_complete(bar, x, nloc, nx); st[0] = nloc; st[1] = nx; }
    const unsigned old = xb_add(&bar[XB_XSUB(x)], 1u);
    const unsigned gen = old / nloc;
    if (old + 1u == (gen + 1u) * nloc) {
      __builtin_amdgcn_fence(__ATOMIC_RELEASE, "agent");
      asm volatile("s_waitcnt vmcnt(0)" ::: "memory");
      const unsigned og = xb_add(&bar[XB_TOP], 1u);
      const unsigned tg = og / nx;
      if (og + 1u == (tg + 1u) * nx) xb_add(&bar[XB_TOPGEN], 1u);
      else XB_SPIN(xb_ld(&bar[XB_TOPGEN]) == tg, bar);
      __builtin_amdgcn_fence(__ATOMIC_ACQUIRE, "agent");
      xb_add(&bar[XB_XGEN(x)], 1u);
      asm volatile("s_waitcnt vmcnt(0)" ::: "memory");
    } else {
      XB_SPIN(xb_ld(&bar[XB_XGEN(x)]) == gen, bar);
      __builtin_amdgcn_fence(__ATOMIC_ACQUIRE, "agent");
      asm volatile("s_waitcnt vmcnt(0)" ::: "memory");
    }
  }
  __syncthreads();
}

DI void hbar(unsigned* cnt) {
  asm volatile("s_waitcnt lgkmcnt(0)" ::: "memory");
  unsigned old = 0;
  if ((opaque_tid() & 63) == 0) old = __hip_atomic_fetch_add(cnt, 1u, __ATOMIC_RELAXED, __HIP_MEMORY_SCOPE_WORKGROUP);
  old = (unsigned)__builtin_amdgcn_readfirstlane((int)old);
  const unsigned target = (old / 4u + 1u) * 4u;
  while (__hip_atomic_load(cnt, __ATOMIC_RELAXED, __HIP_MEMORY_SCOPE_WORKGROUP) < target) __builtin_amdgcn_s_sleep(1);
  asm volatile("s_waitcnt lgkmcnt(0)" ::: "memory");
}

DI int ropeperm(int j) { return ((j >> 5) & 1) * 64 + (j >> 6) * 32 + (j & 31); }
DI int incol(int np) {
  const int tn = np >> 7, j = np & 127;
  if (tn < 16) return np;
  if (tn < 20) return 2048 + (tn - 16) * 128 + ropeperm(j);
  if (tn == 20) return 2560 + j;
  if (tn == 21) return 2688 + j;
  if (tn == 22) return 2816 + ropeperm(j);
  if (tn == 23) return 2944 + j;
  if (tn == 24) return 3072 + ropeperm(j);
  if (tn == 25) return 3200 + j;
  if (tn < 30) return 3340 + (tn - 26) * 128 + j;
  if (tn < 42) return 3852 + (tn - 30) * 128 + j;
  if (tn < 46) return 5392 + (tn - 42) * 128 + j;
  if (tn < 50) return 5904 + (tn - 46) * 128 + j;
  if (tn < 54) return 6480 + (tn - 50) * 128 + j;
  if (j < 64) return 6416 + j;
  if (j < 76) return 3328 + (j - 64);
  if (j < 80) return 5388 + (j - 76);
  return -1;
}
DI int colmap(int kind, int np) {
  if (kind == 0) return np;
  if (kind == 1) return incol(np);
  const int tn = np >> 7, j = np & 127;
  if (kind == 2) { if (tn < 4) return tn * 192 + j; const int hd = (tn - 4) * 2 + (j >> 6); return hd * 192 + 128 + (j & 63); }
  if (tn < 4) return tn * 256 + j;
  return (tn - 4) * 256 + 128 + j;
}

DI void tconv(float* sT, const float* __restrict__ src, int ldsrc, u16* __restrict__ dst, int lddst, int k0, int n0, int kind, const float* __restrict__ gk) {
  const int tid = vtid();
  const int c4 = (tid & 15) * 4, rr = tid >> 4;
  const int sc = colmap(kind, n0 + c4);
  f32x4 v[4];
#pragma unroll
  for (int i = 0; i < 4; ++i) {
    const int k = rr + 16 * i;
    if (sc >= 0) v[i] = *(const f32x4*)&src[(long)(k0 + k) * ldsrc + sc];
    else { v[i][0] = 0.f; v[i][1] = 0.f; v[i][2] = 0.f; v[i][3] = 0.f; }
  }
#pragma unroll
  for (int i = 0; i < 4; ++i) {
    const int k = rr + 16 * i;
    const float g = gk ? gk[k0 + k] : 1.f;
    sT[k * 65 + c4 + 0] = v[i][0] * g; sT[k * 65 + c4 + 1] = v[i][1] * g; sT[k * 65 + c4 + 2] = v[i][2] * g; sT[k * 65 + c4 + 3] = v[i][3] * g;
  }
  __syncthreads();
  const int k2 = (tid & 31) * 2, n = tid >> 5;
#pragma unroll
  for (int i = 0; i < 8; ++i) {
    const int nn = n + 8 * i;
    *(unsigned*)&dst[(long)(n0 + nn) * lddst + k0 + k2] = pk2(sT[k2 * 65 + nn], sT[(k2 + 1) * 65 + nn]);
  }
  __syncthreads();
}

DI void tconv_load(f32x4 (&v)[4], const float* __restrict__ src, int ldsrc, int k0, int n0, int kind) {
  const int tid = vtid();
  const int c4 = (tid & 15) * 4, rr = tid >> 4;
  const int sc = colmap(kind, n0 + c4);
#pragma unroll
  for (int i = 0; i < 4; ++i) {
    const int k = rr + 16 * i;
    if (sc >= 0) v[i] = *(const f32x4*)&src[(long)(k0 + k) * ldsrc + sc];
    else { v[i][0] = 0.f; v[i][1] = 0.f; v[i][2] = 0.f; v[i][3] = 0.f; }
  }
}
DI void tconv_lds(float* sT, const f32x4 (&v)[4]) {
  const int tid = vtid();
  const int c4 = (tid & 15) * 4, rr = tid >> 4;
#pragma unroll
  for (int i = 0; i < 4; ++i) {
    const int k = rr + 16 * i;
    sT[k * 65 + c4 + 0] = v[i][0]; sT[k * 65 + c4 + 1] = v[i][1]; sT[k * 65 + c4 + 2] = v[i][2]; sT[k * 65 + c4 + 3] = v[i][3];
  }
}
DI void tconv_out(const float* sT, u16* __restrict__ dst, int lddst, int k0, int n0) {
  const int tid = vtid();
  const int k2 = (tid & 31) * 2, n = tid >> 5;
#pragma unroll
  for (int i = 0; i < 8; ++i) {
    const int nn = n + 8 * i;
    *(unsigned*)&dst[(long)(n0 + nn) * lddst + k0 + k2] = pk2(sT[k2 * 65 + nn], sT[(k2 + 1) * 65 + nn]);
  }
}
DI void bigw_desc(const P& p, int it, const float*& src, int& ldsrc, u16*& dst, int& k0, int& n0, int& kind) {
  if (it < 7040) {
    const int l = it / 3520, r = it % 3520; const int nt = r >> 5, kt = r & 31;
    src = p.w_in + (long)l * D_ * NINO; ldsrc = NINO; dst = ((u16*)(p.ws + OFF_wt_in)) + (long)l * NINP * D_; k0 = kt * 64; n0 = nt * 64; kind = 1;
  } else {
    const int i2 = it - 7040; const int l = i2 >> 10, r = i2 & 1023; const int nt = r >> 5, kt = r & 31;
    src = p.w_out + (long)l * D_ * D_; ldsrc = D_; dst = ((u16*)(p.ws + OFF_wt_out)) + (long)l * D_ * D_; k0 = kt * 64; n0 = nt * 64; kind = 0;
  }
}

DI void norm_row(const P& p, int row, int mode, const float* __restrict__ xprev, const u16* __restrict__ y, const float* __restrict__ postg,
                 float* __restrict__ xout, const float* __restrict__ preg, u16* __restrict__ hout) {
  const int lane = vtid() & 63;
  f32x4 xv[8];
  const long base = (long)row * D_;
#pragma unroll
  for (int j = 0; j < 8; ++j) xv[j] = *(const f32x4*)&xprev[base + (j * 64 + lane) * 4];
  if (mode == 1) {
    f32x4 yv[8];
    float ss = 0.f;
#pragma unroll
    for (int j = 0; j < 8; ++j) { const u32x2 yb = *(const u32x2*)&y[base + (j * 64 + lane) * 4]; yv[j][0] = __uint_as_float(yb[0] << 16); yv[j][1] = __uint_as_float(yb[0] & 0xffff0000u); yv[j][2] = __uint_as_float(yb[1] << 16); yv[j][3] = __uint_as_float(yb[1] & 0xffff0000u); ss += yv[j][0] * yv[j][0] + yv[j][1] * yv[j][1] + yv[j][2] * yv[j][2] + yv[j][3] * yv[j][3]; }
#pragma unroll
    for (int o = 32; o > 0; o >>= 1) ss += __shfl_xor(ss, o);
    const float rs = rsqrtf(ss * (1.f / D_) + 1e-6f);
#pragma unroll
    for (int j = 0; j < 8; ++j) {
      const f32x4 g = *(const f32x4*)&postg[(j * 64 + lane) * 4];
      xv[j][0] += yv[j][0] * rs * g[0]; xv[j][1] += yv[j][1] * rs * g[1]; xv[j][2] += yv[j][2] * rs * g[2]; xv[j][3] += yv[j][3] * rs * g[3];
      *(f32x4*)&xout[base + (j * 64 + lane) * 4] = xv[j];
    }
  }
  if (preg) {
    float ss = 0.f;
#pragma unroll
    for (int j = 0; j < 8; ++j) ss += xv[j][0] * xv[j][0] + xv[j][1] * xv[j][1] + xv[j][2] * xv[j][2] + xv[j][3] * xv[j][3];
#pragma unroll
    for (int o = 32; o > 0; o >>= 1) ss += __shfl_xor(ss, o);
    const float rs = rsqrtf(ss * (1.f / D_) + 1e-6f);
#pragma unroll
    for (int j = 0; j < 8; ++j) {
      const f32x4 g = *(const f32x4*)&preg[(j * 64 + lane) * 4];
      u32x2 o2; o2[0] = pk2(xv[j][0] * rs * g[0], xv[j][1] * rs * g[1]); o2[1] = pk2(xv[j][2] * rs * g[2], xv[j][3] * rs * g[3]);
      *(u32x2*)&hout[base + (j * 64 + lane) * 4] = o2;
    }
  }
}

DI void phase0(const P& p, char* smem) {
  const int half = vhalf();
  float* sT = (float*)(smem + half * HALF_BYTES);
  const int tid = vtid();
  const int vb = (int)blockIdx.x * 2 + half, vg = (int)gridDim.x * 2;
  constexpr int nA = 7040, nB = 2048, nC = 512, nD = 16, nE = 144, nF = 64;
  constexpr int oB = nA, oC = oB + nB, oD = oC + nC, oE = oD + nD, oF = oE + nE, oG = oF + nF;
  constexpr int nG = 56, nH = 128, nI = 512, nK = 2048;
  constexpr int oH = oG + nG, oI = oH + nH, oK = oI + nI, total = oK + nK;
  {
    int it = vb;
    f32x4 v[4];
    const float* src; int ldsrc; u16* dst; int k0, n0, kind;
    if (it < oC) { bigw_desc(p, it, src, ldsrc, dst, k0, n0, kind); tconv_load(v, src, ldsrc, k0, n0, kind); }
    while (it < oC) {
      tconv_lds(sT, v);
      __syncthreads();
      const int nxt = it + vg;
      const float* src2 = src; int ldsrc2 = ldsrc; u16* dst2 = dst; int k02 = k0, n02 = n0, kind2 = kind;
      if (nxt < oC) { bigw_desc(p, nxt, src2, ldsrc2, dst2, k02, n02, kind2); tconv_load(v, src2, ldsrc2, k02, n02, kind2); }
      tconv_out(sT, dst, D_, k0, n0);
      __syncthreads();
      it = nxt; src = src2; ldsrc = ldsrc2; dst = dst2; k0 = k02; n0 = n02; kind = kind2;
    }
  }
  for (int it = oC + vb; it < total; it += vg) {
    if (it < oB) {
      const int l = it / 3520, r = it % 3520; const int nt = r >> 5, kt = r & 31;
      tconv(sT, p.w_in + (long)l * D_ * NINO, NINO, ((u16*)(p.ws + OFF_wt_in)) + (long)l * NINP * D_, D_, kt * 64, nt * 64, 1, nullptr);
    } else if (it < oC) {
      const int i2 = it - oB; const int l = i2 >> 10, r = i2 & 1023; const int nt = r >> 5, kt = r & 31;
      tconv(sT, p.w_out + (long)l * D_ * D_, D_, ((u16*)(p.ws + OFF_wt_out)) + (long)l * D_ * D_, D_, kt * 64, nt * 64, 0, nullptr);
    } else if (it < oD) {
      const int i2 = it - oC; const int ls = i2 >> 7, r = i2 & 127; const int nt = r >> 6, kt = r & 63;
      const float* src = ((ls & 1) ? p.w1_v : p.w1_k) + (long)(ls >> 1) * 4096 * 128;
      tconv(sT, src, 128, ((u16*)(p.ws + OFF_w1t)) + (long)ls * 128 * 4096, 4096, kt * 64, nt * 64, 0, nullptr);
    } else if (it < oE) {
      const int i2 = it - oD; const int ls = i2 >> 2, r = i2 & 3; const int nt = r >> 1, kt = r & 1;
      const float* src = ((ls & 1) ? p.w2_v : p.w2_k) + (long)(ls >> 1) * 128 * 128;
      tconv(sT, src, 128, ((u16*)(p.ws + OFF_w2t)) + (long)ls * 128 * 128, 128, kt * 64, nt * 64, 0, nullptr);
    } else if (it < oF) {
      const int i2 = it - oE; const int l = i2 / 72, r = i2 % 72; const int nt = r / 6, kt = r % 6;
      tconv(sT, p.w_uq + (long)l * 384 * 768, 768, ((u16*)(p.ws + OFF_wuqt)) + (long)l * 768 * 384, 384, kt * 64, nt * 64, 2, p.qn_g + l * 384);
    } else if (it < oG) {
      const int i2 = it - oF; const int l = i2 >> 5, r = i2 & 31; const int nt = r >> 1, kt = r & 1;
      tconv(sT, p.w_ukv + (long)l * 128 * 1024, 1024, ((u16*)(p.ws + OFF_wukvt)) + (long)l * 1024 * 128, 128, kt * 64, nt * 64, 3, p.kvn_g + l * 128);
    } else if (it < oH) {
      const int i2 = it - oG;
      const int idx = i2 * 256 + tid;
      if (idx < 2 * NINP) { const int l = idx / NINP, np = idx % NINP; const int sc = incol(np); ((float*)(p.ws + OFF_bperm))[idx] = sc >= 0 ? p.b_in[l * NINO + sc] : 0.f; }
    } else if (it < oI) {
      const int i2 = it - oH; const int ls = i2 >> 5, c = i2 & 31;
      const float* w1 = ((ls & 1) ? p.w1_v : p.w1_k) + (long)(ls >> 1) * 4096 * 128;
      const float* pe = ((ls & 1) ? p.pos_v : p.pos_k) + (long)(ls >> 1) * 4096;
      const int n = tid & 127, hf = tid >> 7;
      float a = 0.f;
#pragma unroll 8
      for (int i = 0; i < 64; ++i) { const int k = c * 128 + hf * 64 + i; a += pe[k] * w1[(long)k * 128 + n]; }
      sT[tid] = a;
      __syncthreads();
      if (tid < 128) ((float*)(p.ws + OFF_c1part))[(ls * 32 + c) * 128 + tid] = sT[tid] + sT[tid + 128];
      __syncthreads();
    } else if (it < oK) {
      const int idx = (it - oI) * 256 + tid; const int pos = idx >> 6, f = idx & 63;
      const float inv = powf(10000.f, -(float)f / 64.f);
      const float ang = (float)pos * inv;
      float sn, cs; sincosf(ang, &sn, &cs);
      ((float*)(p.ws + OFF_ropec))[idx] = cs; ((float*)(p.ws + OFF_ropes))[idx] = sn;
    } else {
      const int row = (it - oK) * 4 + (tid >> 6);
      norm_row(p, row, 0, p.x, nullptr, nullptr, nullptr, p.pre_g, ((u16*)(p.ws + OFF_H)));
    }
  }
}

template <int WR, int WC, int RB, int CB, int GBK, int NT, class Epi>
DI void gemm_tile(char* smem, const u16* __restrict__ A, int lda, const u16* __restrict__ Bt, int ldb, int K, Epi epi) {
  constexpr int BM = WR * RB * 32, BN = WC * CB * 32;
  constexpr int GLD = GBK + 8;
  constexpr int CPR = GBK / 8;
  constexpr int RPP = NT / CPR;
  constexpr int NA = BM / RPP, NB = BN / RPP;
  constexpr bool DB = (NT == 512);
  constexpr int STAGE = (BM + BN) * GLD;
  u16* sbase = (u16*)smem;
  const int tid = opaque_tid() & (NT - 1), wave = tid >> 6, lane = tid & 63, r = lane & 31, h = lane >> 5;
  const int wr = wave / WC, wc = wave % WC;
  f32x16 acc[RB][CB];
#pragma unroll
  for (int i = 0; i < RB; ++i)
#pragma unroll
    for (int j = 0; j < CB; ++j) acc[i][j] = zero16();
  u32x4 ra[NA], rb[NB];
  const unsigned trow = (unsigned)tid / CPR, tcol = ((unsigned)tid % CPR) * 8;
  const unsigned voffA = (trow * (unsigned)lda + tcol) * 2u, voffB = (trow * (unsigned)ldb + tcol) * 2u;
  const unsigned soff = (trow * GLD + tcol) * 2u;
#pragma unroll
  for (int i = 0; i < NA; ++i) ra[i] = *(const u32x4*)((const char*)(A + (long)i * RPP * lda) + voffA);
#pragma unroll
  for (int i = 0; i < NB; ++i) rb[i] = *(const u32x4*)((const char*)(Bt + (long)i * RPP * ldb) + voffB);
  if (DB) {
    __syncthreads();
#pragma unroll
    for (int i = 0; i < NA; ++i) *(u32x4*)((char*)sbase + i * RPP * GLD * 2 + soff) = ra[i];
#pragma unroll
    for (int i = 0; i < NB; ++i) *(u32x4*)((char*)(sbase + BM * GLD) + i * RPP * GLD * 2 + soff) = rb[i];
    {
      const int k1 = GBK < K ? GBK : 0;
#pragma unroll
      for (int i = 0; i < NA; ++i) ra[i] = *(const u32x4*)((const char*)(A + (long)i * RPP * lda + k1) + voffA);
#pragma unroll
      for (int i = 0; i < NB; ++i) rb[i] = *(const u32x4*)((const char*)(Bt + (long)i * RPP * ldb + k1) + voffB);
    }
    __syncthreads();
  }
  int cur = 0;
  for (int k0 = 0; k0 < K; k0 += GBK) {
    u16* sA = sbase + (DB ? cur * STAGE : 0);
    u16* sB = sA + BM * GLD;
    u16* nA = sbase + (cur ^ 1) * STAGE;
    const int kn2 = (k0 + 2 * GBK < K) ? k0 + 2 * GBK : K - GBK;
    if (!DB) {
      __syncthreads();
#pragma unroll
      for (int i = 0; i < NA; ++i) *(u32x4*)((char*)sA + i * RPP * GLD * 2 + soff) = ra[i];
#pragma unroll
      for (int i = 0; i < NB; ++i) *(u32x4*)((char*)sB + i * RPP * GLD * 2 + soff) = rb[i];
      __syncthreads();
      if (k0 + GBK < K) {
#pragma unroll
        for (int i = 0; i < NA; ++i) ra[i] = *(const u32x4*)((const char*)(A + (long)i * RPP * lda + k0 + GBK) + voffA);
#pragma unroll
        for (int i = 0; i < NB; ++i) rb[i] = *(const u32x4*)((const char*)(Bt + (long)i * RPP * ldb + k0 + GBK) + voffB);
      }
    }
    {
      bf16x8 af[2][RB], bfr[2][CB];
#pragma unroll
      for (int i = 0; i < RB; ++i) af[0][i] = *(const bf16x8*)&sA[((wr * RB + i) * 32 + r) * GLD + h * 8];
#pragma unroll
      for (int j = 0; j < CB; ++j) bfr[0][j] = *(const bf16x8*)&sB[((wc * CB + j) * 32 + r) * GLD + h * 8];
#pragma unroll
      for (int ks = 0; ks < GBK / 16; ++ks) {
        if (ks + 1 < GBK / 16) {
#pragma unroll
          for (int i = 0; i < RB; ++i) af[(ks + 1) & 1][i] = *(const bf16x8*)&sA[((wr * RB + i) * 32 + r) * GLD + (ks + 1) * 16 + h * 8];
#pragma unroll
          for (int j = 0; j < CB; ++j) bfr[(ks + 1) & 1][j] = *(const bf16x8*)&sB[((wc * CB + j) * 32 + r) * GLD + (ks + 1) * 16 + h * 8];
        }
#pragma unroll
        for (int i = 0; i < RB; ++i)
#pragma unroll
          for (int j = 0; j < CB; ++j) acc[i][j] = mfma(af[ks & 1][i], bfr[ks & 1][j], acc[i][j]);
        if (DB) {
          if (ks < NA) { *(u32x4*)((char*)nA + ks * RPP * GLD * 2 + soff) = ra[ks]; ra[ks] = *(const u32x4*)((const char*)(A + (long)ks * RPP * lda + kn2) + voffA); }
          if (ks < NB) { *(u32x4*)((char*)(nA + BM * GLD) + ks * RPP * GLD * 2 + soff) = rb[ks]; rb[ks] = *(const u32x4*)((const char*)(Bt + (long)ks * RPP * ldb + kn2) + voffB); }
        }
        if (ks + 1 < GBK / 16) __builtin_amdgcn_sched_group_barrier(0x100, RB + CB, 0);
        __builtin_amdgcn_sched_group_barrier(0x008, RB * CB, 0);
      }
    }
    if (DB) { __syncthreads(); cur ^= 1; }
  }
  epi(acc, wr, wc, r, h);
}

DI void store_vt(const f32x16& a, u16* __restrict__ dst  ) {
#pragma unroll
  for (int s = 0; s < 2; ++s) {
    u32x4 v; v[0] = pk2(a[8 * s], a[8 * s + 1]); v[1] = pk2(a[8 * s + 2], a[8 * s + 3]); v[2] = pk2(a[8 * s + 4], a[8 * s + 5]); v[3] = pk2(a[8 * s + 6], a[8 * s + 7]);
    *(u32x4*)(dst + 16 * s) = v;
  }
}

template <int RB>
DI void g1_epilogue(const P& p, int layer, f32x16 (&acc)[RB][2], int m0, int tn, int cbase, int rowbase, int r, int h) {
  if (tn > 54) return;
  const float* bias = ((float*)(p.ws + OFF_bperm)) + layer * NINP + tn * 128 + cbase;
  const int b = m0 >> 11, sb0 = m0 & 2047;
#pragma unroll
  for (int jj = 0; jj < 2; ++jj) {
    const float bv = bias[jj * 32 + r];
#pragma unroll
    for (int i = 0; i < RB; ++i)
#pragma unroll
      for (int e = 0; e < 16; ++e) acc[i][jj][e] += bv;
  }
  int kind; u16* dst = nullptr; int ld = 0, coloff = 0; float scale = 1.f; int nh = 1, hd = 0;
  const float qs = 0.08838834764831845f * 1.4426950408889634f;
  if (tn < 4) { kind = 0; dst = ((u16*)(p.ws + OFF_SBQ)); ld = 512; coloff = tn * 128; scale = qs; }
  else if (tn < 8) { kind = 0; dst = ((u16*)(p.ws + OFF_SBK)); ld = 512; coloff = (tn - 4) * 128; }
  else if (tn < 12) { kind = 2; dst = ((u16*)(p.ws + OFF_SBVt)); nh = 4; hd = tn - 8; }
  else if (tn < 16) { kind = 3; coloff = (tn - 12) * 128; }
  else if (tn < 20) { kind = 1; dst = ((u16*)(p.ws + OFF_NQ)); ld = 512; coloff = (tn - 16) * 128; scale = qs; }
  else if (tn == 20) { kind = 0; dst = ((u16*)(p.ws + OFF_KCT)); ld = 128; }
  else if (tn == 21) { kind = 0; dst = ((u16*)(p.ws + OFF_VCT)); ld = 128; }
  else if (tn == 22) { kind = 1; dst = ((u16*)(p.ws + OFF_KSEL)); ld = 128; }
  else if (tn == 23) { kind = 2; dst = ((u16*)(p.ws + OFF_VSELt)); }
  else if (tn == 24) { kind = 1; dst = ((u16*)(p.ws + OFF_KWIN)); ld = 128; }
  else if (tn == 25) { kind = 2; dst = ((u16*)(p.ws + OFF_VWINt)); }
  else if (tn < 30) { kind = 3; coloff = 512 + (tn - 26) * 128; }
  else if (tn < 34) { kind = 0; dst = ((u16*)(p.ws + OFF_FQ)); ld = 512; coloff = (tn - 30) * 128; scale = qs; }
  else if (tn < 38) { kind = 0; dst = ((u16*)(p.ws + OFF_FK)); ld = 512; coloff = (tn - 34) * 128; }
  else if (tn < 42) { kind = 2; dst = ((u16*)(p.ws + OFF_FVt)); nh = 4; hd = tn - 38; }
  else if (tn < 46) { kind = 3; coloff = 1024 + (tn - 42) * 128; }
  else if (tn < 49) { kind = 0; dst = ((u16*)(p.ws + OFF_CQ)); ld = 384; coloff = (tn - 46) * 128; }
  else if (tn == 49) { kind = 0; dst = ((u16*)(p.ws + OFF_CKV)); ld = 128; }
  else if (tn < 54) { kind = 3; coloff = 1536 + (tn - 50) * 128; }
  else kind = 4;
  if (kind == 3) { kind = 0; dst = ((u16*)(p.ws + OFF_G)); ld = 2048; scale = 0.f; }
  if (kind == 0) {
    if (__builtin_amdgcn_readfirstlane(scale == 0.f)) {
#pragma unroll
      for (int i = 0; i < RB; ++i)
#pragma unroll
        for (int jj = 0; jj < 2; ++jj)
#pragma unroll
          for (int e = 0; e < 16; ++e) {
            const int m = m0 + rowbase + i * 32 + crow(e, h);
            dst[(long)m * ld + coloff + cbase + jj * 32 + r] = f2bf(silu_f(acc[i][jj][e]));
          }
    } else {
#pragma unroll
      for (int i = 0; i < RB; ++i)
#pragma unroll
        for (int jj = 0; jj < 2; ++jj)
#pragma unroll
          for (int e = 0; e < 16; ++e) {
            const int m = m0 + rowbase + i * 32 + crow(e, h);
            dst[(long)m * ld + coloff + cbase + jj * 32 + r] = f2bf(acc[i][jj][e] * scale);
          }
    }
  } else if (kind == 1) {
    const int f = (cbase >> 6) * 32 + r;
#pragma unroll
    for (int i = 0; i < RB; ++i)
#pragma unroll
      for (int e = 0; e < 16; ++e) {
        const int m = m0 + rowbase + i * 32 + crow(e, h);
        const int pos = m & 2047;
        const float cs = ((float*)(p.ws + OFF_ropec))[pos * 64 + f], sn = ((float*)(p.ws + OFF_ropes))[pos * 64 + f];
        const float x1 = acc[i][0][e], x2 = acc[i][1][e];
        dst[(long)m * ld + coloff + f] = f2bf((x1 * cs - x2 * sn) * scale);
        dst[(long)m * ld + coloff + 64 + f] = f2bf((x2 * cs + x1 * sn) * scale);
      }
  } else if (kind == 2) {
#pragma unroll
    for (int i = 0; i < RB; ++i)
#pragma unroll
      for (int jj = 0; jj < 2; ++jj) {
        const int d = cbase + jj * 32 + r;
        u16* o = dst + ((long)((b * nh + hd) * 128 + d)) * S_ + sb0 + rowbase + i * 32 + 8 * h;
        store_vt(acc[i][jj], o);
      }
  } else {
    const float* fbias = p.fb + layer * 4;
    if (cbase == 0) {
#pragma unroll
      for (int i = 0; i < RB; ++i)
#pragma unroll
        for (int e = 0; e < 16; ++e) {
          const int m = m0 + rowbase + i * 32 + crow(e, h);
          const int pos = m & 2047;
          const float cs = ((float*)(p.ws + OFF_ropec))[pos * 64 + 2 * r], sn = ((float*)(p.ws + OFF_ropes))[pos * 64 + 2 * r];
          const float x1 = acc[i][0][e], x2 = acc[i][1][e];
          ((u16*)(p.ws + OFF_KR))[(long)m * 64 + r] = f2bf(x1 * cs - x2 * sn);
          ((u16*)(p.ws + OFF_KR))[(long)m * 64 + 32 + r] = f2bf(x2 * cs + x1 * sn);
        }
    } else {
      if (r < 16) {
        const float fbv = r >= 12 ? fbias[r - 12] : 0.f;
#pragma unroll
        for (int i = 0; i < RB; ++i)
#pragma unroll
          for (int e = 0; e < 16; ++e) {
            const int m = m0 + rowbase + i * 32 + crow(e, h);
            const float v = acc[i][0][e];
            if (r < 12) ((float*)(p.ws + OFF_BR))[(long)m * 12 + r] = sigmoid_f(v);
            else ((float*)(p.ws + OFF_LOGF))[(long)m * 4 + (r - 12)] = logsigmoid_f(v + fbv);
          }
      }
    }
  }
}

DI void phase_g1(const P& p, int layer, char* smem) {
  const u16* Wt = ((u16*)(p.ws + OFF_wt_in)) + (long)layer * NINP * D_;
  constexpr int NBIG = 32 * 24, NSMALL = 32 * 7;
  for (int t = blockIdx.x; t < NBIG + NSMALL; t += gridDim.x) {
    if (t < NBIG) {
      const int xcd = t & 7, j = t >> 3;
      const int mt = xcd * 4 + (j & 3), tnb = j >> 2;
      const int m0 = mt * 256, n0 = tnb * 256;
      auto epi = [&](f32x16 (&acc)[4][2], int wr, int wc, int r, int h) { g1_epilogue<4>(p, layer, acc, m0, tnb * 2 + (wc >> 1), (wc & 1) * 64, wr * 128, r, h); };
      gemm_tile<2, 4, 4, 2, 64, 512>(smem, ((u16*)(p.ws + OFF_H)) + (long)m0 * D_, D_, Wt + (long)n0 * D_, D_, D_, epi);
    } else {
      const int t2 = t - NBIG;
      const int xcd = t2 & 7, j = t2 >> 3;
      const int mt = xcd * 4 + (j & 3), tn = 48 + (j >> 2);
      const int m0 = mt * 256, n0 = tn * 128;
      auto epi = [&](f32x16 (&acc)[2][2], int wr, int wc, int r, int h) { g1_epilogue<2>(p, layer, acc, m0, tn, wc * 64, wr * 64, r, h); };
      gemm_tile<4, 2, 2, 2, 64, 512>(smem, ((u16*)(p.ws + OFF_H)) + (long)m0 * D_, D_, Wt + (long)n0 * D_, D_, D_, epi);
    }
  }
}

DI void phase_prep(const P& p, int layer, char* smem) {
  float* sR = (float*)(smem + 2 * 512 * 72 * 2);
  constexpr int nCmp = 64, nCum = 8, nUQ = 32 * 3, nUKV = 32 * 4;
  int* sFlag = (int*)(smem + SH_OFF + 256);
  constexpr int oCum = nCmp, oUQ = oCum + nCum, oUKV = oUQ + nUQ, total = oUKV + nUKV;
  for (int it = blockIdx.x; it < total; it += gridDim.x) {
    const int tid = vtid(), half = vhalf();
    __syncthreads();
    if (it < oCum) {
      char* hs = smem + half * HALF_BYTES;
      const int kq = it & 3, grp = it >> 2;
      const int st = half, b = (grp >> 2) & 3, mt = grp & 3;
      const int ls = layer * 2 + st;
      const u16* tok = (st ? ((u16*)(p.ws + OFF_VCT)) : ((u16*)(p.ws + OFF_KCT))) + (long)b * S_ * 128;
      f32x16 hacc;
      auto epi1 = [&](f32x16 (&acc)[1][1], int wr, int wc, int r, int h) { hacc = acc[0][0]; };
      gemm_tile<1, 4, 1, 1, 128, 256>(hs, tok + (long)mt * 32 * 2048 + kq * 1024, 2048, ((u16*)(p.ws + OFF_w1t)) + (long)ls * 128 * 4096 + kq * 1024, 4096, 1024, epi1);
      {
        const int wave = tid >> 6, lane = tid & 63, r = lane & 31, h = lane >> 5;
        float* pgrp = ((float*)(p.ws + OFF_PART)) + (long)(grp * 2 + st) * 4 * 4096;
#pragma unroll
        for (int e = 0; e < 16; ++e) pgrp[kq * 4096 + crow(e, h) * 128 + wave * 32 + r] = hacc[e];
        asm volatile("s_waitcnt vmcnt(0)" ::: "memory");
        __syncthreads();
        if (opaque_tid() == 0) {
          __builtin_amdgcn_fence(__ATOMIC_RELEASE, "agent");
          asm volatile("s_waitcnt vmcnt(0)" ::: "memory");
          *sFlag = (int)xb_add(((unsigned*)(p.ws + OFF_ctr)) + XB_CMPCNT + layer * 16 + grp, 1u);
        }
        __syncthreads();
        if ((*sFlag & 3) != 3) continue;
        if (opaque_tid() == 0) {
          __builtin_amdgcn_fence(__ATOMIC_ACQUIRE, "agent");
          asm volatile("s_waitcnt vmcnt(0)" ::: "memory");
        }
        __syncthreads();
#pragma unroll
        for (int e = 0; e < 16; ++e) {
          const int o = crow(e, h) * 128 + wave * 32 + r;
          hacc[e] = (pgrp[o] + pgrp[4096 + o]) + (pgrp[2 * 4096 + o] + pgrp[3 * 4096 + o]);
        }
      }
      const int wave = tid >> 6, lane = tid & 63, r = lane & 31, h = lane >> 5;
      __syncthreads();
      u16* sH = (u16*)hs;
      float* sO = (float*)(hs + 16384);
      {
        const int col = wave * 32 + r;
        float c1 = 0.f;
        for (int c = 0; c < 32; ++c) c1 += ((float*)(p.ws + OFF_c1part))[(ls * 32 + c) * 128 + col];
#pragma unroll
        for (int e = 0; e < 16; ++e) sH[crow(e, h) * 136 + col] = f2bf(silu_f(hacc[e] + c1));
      }
      __syncthreads();
      {
        f32x16 o = zero16();
        const u16* w2 = ((u16*)(p.ws + OFF_w2t)) + (long)ls * 128 * 128;
#pragma unroll
        for (int ks = 0; ks < 8; ++ks) {
          const bf16x8 a = *(const bf16x8*)&sH[r * 136 + ks * 16 + h * 8];
          const bf16x8 bb = *(const bf16x8*)&w2[(wave * 32 + r) * 128 + ks * 16 + h * 8];
          o = mfma(a, bb, o);
        }
#pragma unroll
        for (int e = 0; e < 16; ++e) sO[crow(e, h) * 129 + wave * 32 + r] = o[e];
      }
      __syncthreads();
      if (st == 0) {
        for (int idx = tid; idx < 32 * 64; idx += VT) {
          const int row = idx >> 6, f = idx & 63; const int n = mt * 32 + row;
          float o1 = 0.f, o2 = 0.f;
          if (n < 127) {
            const int pos = 16 * n + 31;
            const float cs = ((float*)(p.ws + OFF_ropec))[pos * 64 + f], sn = ((float*)(p.ws + OFF_ropes))[pos * 64 + f];
            const float x1 = sO[row * 129 + f], x2 = sO[row * 129 + 64 + f];
            o1 = x1 * cs - x2 * sn; o2 = x2 * cs + x1 * sn;
          }
          ((u16*)(p.ws + OFF_KC))[((long)b * 128 + n) * 128 + f] = f2bf(o1);
          ((u16*)(p.ws + OFF_KC))[((long)b * 128 + n) * 128 + 64 + f] = f2bf(o2);
        }
      } else {
        for (int idx = tid; idx < 32 * 128; idx += VT) {
          const int d = idx >> 5, row = idx & 31; const int n = mt * 32 + row;
          const float v = n < 127 ? sO[row * 129 + d] : 0.f;
          const int m16 = n & 15; const int pp = (n & ~15) + 8 * ((m16 >> 2) & 1) + 4 * (m16 >> 3) + (m16 & 3);
          ((u16*)(p.ws + OFF_VCt))[((long)b * 128 + d) * 128 + pp] = f2bf(v);
        }
      }
    } else if (it < oUQ) {
      const int bh = (it - oCum) * 2 + half; const int b = bh >> 2, hh = bh & 3;
      if (tid < 64) {
        const float* lf = ((float*)(p.ws + OFF_LOGF)) + (long)b * S_ * 4 + hh;
        float v[32]; float run = 0.f;
#pragma unroll
        for (int i = 0; i < 32; ++i) { run += lf[(long)(tid * 32 + i) * 4]; v[i] = run; }
        float inc = run;
#pragma unroll
        for (int o = 1; o < 64; o <<= 1) { const float t2 = __shfl_up(inc, o); if (tid >= o) inc += t2; }
        const float excl = inc - run;
#pragma unroll
        for (int i = 0; i < 32; ++i) ((float*)(p.ws + OFF_CUM))[(long)bh * S_ + tid * 32 + i] = (v[i] + excl) * 1.4426950408889634f;
      }
    } else {
      const int rt = opaque_tid();
      const bool isq = it < oUKV;
      const int i2 = isq ? it - oUQ : it - oUKV;
      const int ntn = isq ? 3 : 4;
      const int mt = i2 / ntn, tnb = i2 % ntn;
      const int m0 = mt * 256, n0 = tnb * 256;
      const int K = isq ? 384 : 128;
      const u16* A = (isq ? ((u16*)(p.ws + OFF_CQ)) : ((u16*)(p.ws + OFF_CKV))) + (long)m0 * K;
      {
        const int row = rt >> 1, hf = rt & 1;
        const u16* ar = A + (long)row * K + hf * (K / 2);
        float ss = 0.f;
#pragma unroll 8
        for (int c = 0; c < K / 16; ++c) {
          const u32x4 v = *(const u32x4*)(ar + c * 8);
#pragma unroll
          for (int q = 0; q < 4; ++q) { const float lo = __uint_as_float(v[q] << 16), hi = __uint_as_float(v[q] & 0xffff0000u); ss += lo * lo + hi * hi; }
        }
        ss += __shfl_xor(ss, 1);
        if (hf == 0) sR[row] = rsqrtf(ss / (float)K + 1e-6f);
      }
      const u16* Bt = (isq ? ((u16*)(p.ws + OFF_wuqt)) + (long)layer * 768 * 384 : ((u16*)(p.ws + OFF_wukvt)) + (long)layer * 1024 * 128) + (long)n0 * K;
      auto epi = [&](f32x16 (&acc)[4][2], int wr, int wc, int r, int h) {
        const int b = m0 >> 11, sb0 = m0 & 2047;
        const int tn = tnb * 2 + (wc >> 1), cb = (wc & 1) * 64, rb0 = wr * 128;
        const float qs = 0.07216878364870322f * 1.4426950408889634f;
        if (isq) {
          if (tn < 4) {
#pragma unroll
            for (int i = 0; i < 4; ++i)
#pragma unroll
              for (int jj = 0; jj < 2; ++jj)
#pragma unroll
                for (int e = 0; e < 16; ++e) {
                  const int ml = rb0 + i * 32 + crow(e, h);
                  ((u16*)(p.ws + OFF_MQ))[(long)(m0 + ml) * 768 + tn * 192 + cb + jj * 32 + r] = f2bf(acc[i][jj][e] * sR[ml] * qs);
                }
          } else {
            const int hd = (tn - 4) * 2 + (wc & 1);
#pragma unroll
            for (int i = 0; i < 4; ++i)
#pragma unroll
              for (int e = 0; e < 16; ++e) {
                const int ml = rb0 + i * 32 + crow(e, h);
                const int pos = (m0 + ml) & 2047;
                const float cs = ((float*)(p.ws + OFF_ropec))[pos * 64 + 2 * r], sn = ((float*)(p.ws + OFF_ropes))[pos * 64 + 2 * r];
                const float sc = sR[ml] * qs;
                const float x1 = acc[i][0][e] * sc, x2 = acc[i][1][e] * sc;
                ((u16*)(p.ws + OFF_MQ))[(long)(m0 + ml) * 768 + hd * 192 + 128 + r] = f2bf(x1 * cs - x2 * sn);
                ((u16*)(p.ws + OFF_MQ))[(long)(m0 + ml) * 768 + hd * 192 + 160 + r] = f2bf(x2 * cs + x1 * sn);
              }
          }
        } else {
          if (tn < 4) {
#pragma unroll
            for (int i = 0; i < 4; ++i)
#pragma unroll
              for (int jj = 0; jj < 2; ++jj)
#pragma unroll
                for (int e = 0; e < 16; ++e) {
                  const int ml = rb0 + i * 32 + crow(e, h);
                  ((u16*)(p.ws + OFF_MKN))[(long)(m0 + ml) * 512 + tn * 128 + cb + jj * 32 + r] = f2bf(acc[i][jj][e] * sR[ml]);
                }
          } else {
            const int hd = tn - 4;
#pragma unroll
            for (int i = 0; i < 4; ++i)
#pragma unroll
              for (int jj = 0; jj < 2; ++jj) {
                f32x16 a = acc[i][jj];
#pragma unroll
                for (int e = 0; e < 16; ++e) a[e] *= sR[rb0 + i * 32 + crow(e, h)];
                const int d = cb + jj * 32 + r;
                u16* o = ((u16*)(p.ws + OFF_MVt)) + ((long)((b * 4 + hd) * 128 + d)) * S_ + sb0 + rb0 + i * 32 + 8 * h;
                store_vt(a, o);
              }
          }
        }
      };
      gemm_tile<2, 4, 4, 2, 64, 512>(smem, A, K, Bt, K, K, epi);
    }
  }
}

template <int NSTEP, int KLD>
DI void qk_tile(const u16* sK, const bf16x8 (&qf)[NSTEP], f32x16& s0, f32x16& s1, int r, int h) {
  s0 = zero16(); s1 = zero16();
#pragma unroll
  for (int st = 0; st < NSTEP; ++st) {
    const bf16x8 a0 = *(const bf16x8*)&sK[r * KLD + st * 16 + h * 8];
    const bf16x8 a1 = *(const bf16x8*)&sK[(32 + r) * KLD + st * 16 + h * 8];
    s0 = mfma(a0, qf[st], s0);
    s1 = mfma(a1, qf[st], s1);
  }
}
DI void pv_tile(const u16* sV, const f32x16& p0, const f32x16& p1, f32x16 (&o)[4], int r, int h) {
#pragma unroll
  for (int kb = 0; kb < 2; ++kb)
#pragma unroll
    for (int s = 0; s < 2; ++s) {
      const bf16x8 pb = pack8(kb ? p1 : p0, s);
#pragma unroll
      for (int db = 0; db < 4; ++db) {
        const bf16x8 a = *(const bf16x8*)&sV[(db * 32 + r) * VLD + kb * 32 + s * 16 + h * 8];
        o[db] = mfma(a, pb, o[db]);
      }
    }
}
DI void softmax_step(f32x16& s0, f32x16& s1, float& m, float& l, f32x16 (&o)[4]) {
  float tm = -INFINITY;
#pragma unroll
  for (int i = 0; i < 16; ++i) tm = fmaxf(tm, fmaxf(s0[i], s1[i]));
  tm = fmaxf(tm, __shfl_xor(tm, 32));
  const float mn = fmaxf(m, tm);
  const float mu = (mn == -INFINITY) ? 0.f : mn;
  float ps = 0.f;
#pragma unroll
  for (int i = 0; i < 16; ++i) { s0[i] = exp2_f(s0[i] - mu); s1[i] = exp2_f(s1[i] - mu); ps += s0[i] + s1[i]; }
  if (__any(mn != m)) {
    const float alpha = exp2_f(m - mu);
    l *= alpha;
#pragma unroll
    for (int db = 0; db < 4; ++db)
#pragma unroll
      for (int i = 0; i < 16; ++i) o[db][i] *= alpha;
  }
  l += ps;
  m = mn;
}

template <int NCH>
struct KStage { u32x4 v[NCH / 4]; };
template <int NCH>
DI void k_fetch(KStage<NCH>& st, const u16* __restrict__ k1, long ld1, const u16* __restrict__ k2, long ld2) {
  const int tid = vtid();
#pragma unroll
  for (int i = 0; i < NCH / 4; ++i) {
    const int c = tid + VT * i; const int row = c / NCH, ch = c % NCH;
    const u16* src = (NCH > 16 && ch >= 16) ? (k2 + (unsigned)(row * (int)ld2 + (ch - 16) * 8)) : (k1 + (unsigned)(row * (int)ld1 + ch * 8));
    st.v[i] = *(const u32x4*)src;
  }
}
template <int NCH, int KLD>
DI void k_commit(const KStage<NCH>& st, u16* sK) {
  const int tid = vtid();
#pragma unroll
  for (int i = 0; i < NCH / 4; ++i) {
    const int c = tid + VT * i; const int row = c / NCH, ch = c % NCH;
    *(u32x4*)&sK[row * KLD + ch * 8] = st.v[i];
  }
}
struct VStage { u32x4 v[4]; };
DI void v_fetch(VStage& st, const u16* __restrict__ vt, long ldv) {
  const int tid = vtid();
#pragma unroll
  for (int i = 0; i < 4; ++i) { const int c = tid + VT * i; st.v[i] = *(const u32x4*)(vt + (unsigned)((c >> 3) * (int)ldv + (c & 7) * 8)); }
}
DI void v_commit(const VStage& st, u16* sV) {
  const int tid = vtid();
#pragma unroll
  for (int i = 0; i < 4; ++i) { const int c = tid + VT * i; *(u32x4*)&sV[(c >> 3) * VLD + (c & 7) * 8] = st.v[i]; }
}

DI void store_mix(const P& p, const f32x16 (&o)[4], float rowscale, int t, int col0, int h) {
  asm volatile("" : "+v"(t));
  const long base = (long)t * 2048 + col0 + 4 * h;
  const u16* gp = ((u16*)(p.ws + OFF_G)) + base;
  u16* mp = ((u16*)(p.ws + OFF_MIX)) + base;
#pragma unroll
  for (int db = 0; db < 4; ++db)
#pragma unroll
    for (int g = 0; g < 4; ++g) {
      const int d = db * 32 + 8 * g;
      const u32x2 gv = *(const u32x2*)&gp[d];
      const float g0 = __uint_as_float(gv[0] << 16), g1 = __uint_as_float(gv[0] & 0xffff0000u);
      const float g2 = __uint_as_float(gv[1] << 16), g3 = __uint_as_float(gv[1] & 0xffff0000u);
      u32x2 ov;
      ov[0] = pk2(o[db][4 * g] * rowscale * g0, o[db][4 * g + 1] * rowscale * g1);
      ov[1] = pk2(o[db][4 * g + 2] * rowscale * g2, o[db][4 * g + 3] * rowscale * g3);
      *(u32x2*)&mp[d] = ov;
    }
}

template <int TYPE>
DI void attn_causal_item(const P& p, int bh, int qb, char* smem) {
  unsigned* hbc = (unsigned*)(smem + AOFF_HB);
  constexpr int NSTEP = TYPE == 2 ? 12 : 8;
  constexpr int NCH = TYPE == 2 ? 24 : 16;
  constexpr int KLD = TYPE == 2 ? 200 : 136;
  constexpr bool DBUF = TYPE != 2;
  u16* sK = (u16*)smem;
  u16* sV = (u16*)(smem + AOFF_V0);
  float* sC = (float*)(smem + AOFF_C);
  volatile int* sDone = (volatile int*)(smem + AOFF_DONE);
  const int tid = vtid(), wave = tid >> 6, lane = tid & 63, r = lane & 31, h = lane >> 5;
  const int b = bh >> 2, hd = bh & 3;
  const int q0 = qb * 128;
  const int qpos = q0 + wave * 32 + r;
  const long tq = (long)b * S_ + qpos;
  const u16* Qp; const u16* K1; long ld1; const u16* K2 = nullptr; long ld2 = 0; const u16* Vt;
  int col0;
  if (TYPE == 0) { Qp = ((u16*)(p.ws + OFF_SBQ)) + tq * 512 + hd * 128; K1 = ((u16*)(p.ws + OFF_SBK)) + (long)b * S_ * 512 + hd * 128; ld1 = 512; Vt = ((u16*)(p.ws + OFF_SBVt)) + (long)bh * 128 * S_; col0 = hd * 128; }
  else if (TYPE == 1) { Qp = ((u16*)(p.ws + OFF_FQ)) + tq * 512 + hd * 128; K1 = ((u16*)(p.ws + OFF_FK)) + (long)b * S_ * 512 + hd * 128; ld1 = 512; Vt = ((u16*)(p.ws + OFF_FVt)) + (long)bh * 128 * S_; col0 = 1024 + hd * 128; }
  else { Qp = ((u16*)(p.ws + OFF_MQ)) + tq * 768 + hd * 192; K1 = ((u16*)(p.ws + OFF_MKN)) + (long)b * S_ * 512 + hd * 128; ld1 = 512; K2 = ((u16*)(p.ws + OFF_KR)) + (long)b * S_ * 64; ld2 = 64; Vt = ((u16*)(p.ws + OFF_MVt)) + (long)bh * 128 * S_; col0 = 1536 + hd * 128; }
  bf16x8 qf[NSTEP];
#pragma unroll
  for (int st = 0; st < NSTEP; ++st) qf[st] = *(const bf16x8*)(Qp + st * 16 + h * 8);
  const float* cum = ((float*)(p.ws + OFF_CUM)) + (long)bh * S_;
  float cq = 0.f;
  if (TYPE == 1) cq = cum[qpos];
  f32x16 o[4];
#pragma unroll
  for (int db = 0; db < 4; ++db) o[db] = zero16();
  float m = -INFINITY, l = 0.f;
  float carry = 1.f;
  const int nt = 2 * qb + 2;
  KStage<NCH> ks; VStage vs; float cst = 0.f;
  {
    const int key0 = (nt - 1) * 64;
    k_fetch<NCH>(ks, K1 + (long)key0 * ld1, ld1, K2 + (long)key0 * ld2, ld2);
    v_fetch(vs, Vt + key0, S_);
    if (TYPE == 1 && tid < 64) cst = cum[key0 + tid];
  }
  const int qmax_w = q0 + wave * 32 + 31;
  if (TYPE == 0 && tid < 4) sDone[tid] = 0;
  if (DBUF) {
    hbar(hbc);
    k_commit<NCH, KLD>(ks, sK);
    v_commit(vs, sV);
    if (TYPE == 1 && tid < 64) sC[tid] = cst;
    if (nt > 1) {
      const int key0n = (nt - 2) * 64;
      k_fetch<NCH>(ks, K1 + (long)key0n * ld1, ld1, K2 + (long)key0n * ld2, ld2);
      v_fetch(vs, Vt + key0n, S_);
      if (TYPE == 1 && tid < 64) cst = cum[key0n + tid];
    }
    hbar(hbc);
    int cur = 0;
    for (int t = nt - 1; t >= 0; --t) {
      const int key0 = t * 64;
      const u16* sKc = (const u16*)(smem + cur * AOFF_K1); const u16* sVc = (const u16*)(smem + AOFF_V0 + cur * (AOFF_V1 - AOFF_V0)); const float* sCc = sC + cur * 64;
      u16* sKn = (u16*)(smem + (cur ^ 1) * AOFF_K1); u16* sVn = (u16*)(smem + AOFF_V0 + (cur ^ 1) * (AOFF_V1 - AOFF_V0));
      f32x16 s0, s1;
      qk_tile<NSTEP, KLD>(sKc, qf, s0, s1, r, h);
      if (t > 0) { k_commit<NCH, KLD>(ks, sKn); if (TYPE == 1 && tid < 64) sC[(cur ^ 1) * 64 + tid] = cst; }
      {
    if (TYPE == 0) {
#pragma unroll
        for (int i = 0; i < 16; ++i) {
          const int ka = key0 + crow(i, h), kb2 = ka + 32;
          const float f0 = __frcp_rn(1.f + exp2_f(fminf(s0[i], 115.f)));
          const float f1 = __frcp_rn(1.f + exp2_f(fminf(s1[i], 115.f)));
          s0[i] = (ka < qpos) ? f0 : 1.f;
          s1[i] = (kb2 < qpos) ? f1 : 1.f;
        }
        float gs[2][4], pg[2][4];
#pragma unroll
        for (int g = 0; g < 4; ++g) {
          gs[0][g] = (s0[4 * g] * s0[4 * g + 1]) * (s0[4 * g + 2] * s0[4 * g + 3]);
          gs[1][g] = (s1[4 * g] * s1[4 * g + 1]) * (s1[4 * g + 2] * s1[4 * g + 3]);
        }
#pragma unroll
        for (int kb = 0; kb < 2; ++kb)
#pragma unroll
          for (int g = 0; g < 4; ++g) pg[kb][g] = __shfl_xor(gs[kb][g], 32);
        float run = carry;
#pragma unroll
        for (int kb = 1; kb >= 0; --kb)
#pragma unroll
          for (int g = 3; g >= 0; --g) {
            const float after = run * (h == 0 ? pg[kb][g] : 1.f);
            f32x16& sx = kb ? s1 : s0;
            const float a3 = after, a2 = a3 * sx[4 * g + 3], a1 = a2 * sx[4 * g + 2], a0 = a1 * sx[4 * g + 1], am = a0 * sx[4 * g];
            sx[4 * g + 3] = a3 - a2; sx[4 * g + 2] = a2 - a1; sx[4 * g + 1] = a1 - a0; sx[4 * g] = a0 - am;
            run *= gs[kb][g] * pg[kb][g];
          }
        carry = run;
        if (__all(carry == 0.f) && lane == 0) sDone[wave] = 1;
      } else {
        if (TYPE == 1) {
#pragma unroll
          for (int i = 0; i < 16; ++i) { s0[i] += cq - sCc[crow(i, h)]; s1[i] += cq - sCc[32 + crow(i, h)]; }
        }
        if (key0 + 63 > q0 + wave * 32) {
#pragma unroll
          for (int i = 0; i < 16; ++i) {
            const int ka = key0 + crow(i, h), kb2 = ka + 32;
            s0[i] = ka <= qpos ? s0[i] : -INFINITY;
            s1[i] = kb2 <= qpos ? s1[i] : -INFINITY;
          }
        }
        softmax_step(s0, s1, m, l, o);
      }
      }
      if (t > 0) {
        v_commit(vs, sVn);
        if (t > 1) {
          const int key0n = (t - 2) * 64;
          k_fetch<NCH>(ks, K1 + (long)key0n * ld1, ld1, K2 + (long)key0n * ld2, ld2);
          v_fetch(vs, Vt + key0n, S_);
          if (TYPE == 1 && tid < 64) cst = cum[key0n + tid];
        }
      }
      pv_tile(sVc, s0, s1, o, r, h);
      hbar(hbc);
      cur ^= 1;
      if (TYPE == 0 && (sDone[0] & sDone[1] & sDone[2] & sDone[3])) break;
    }
  } else
  for (int t = nt - 1; t >= 0; --t) {
    hbar(hbc);
    if (TYPE == 0 && (sDone[0] & sDone[1] & sDone[2] & sDone[3])) break;
    k_commit<NCH, KLD>(ks, sK);
    v_commit(vs, sV);
    if (TYPE == 1 && tid < 64) sC[tid] = cst;
    hbar(hbc);
    if (t > 0) {
      const int key0n = (t - 1) * 64;
      k_fetch<NCH>(ks, K1 + (long)key0n * ld1, ld1, K2 + (long)key0n * ld2, ld2);
      v_fetch(vs, Vt + key0n, S_);
      if (TYPE == 1 && tid < 64) cst = cum[key0n + tid];
    }
    const int key0 = t * 64;
    if (key0 > qmax_w) continue;
    f32x16 s0, s1;
    qk_tile<NSTEP, KLD>(sK, qf, s0, s1, r, h);
    if (TYPE == 0) {
#pragma unroll
      for (int i = 0; i < 16; ++i) {
        const int ka = key0 + crow(i, h), kb2 = ka + 32;
        const float f0 = __frcp_rn(1.f + exp2_f(fminf(s0[i], 115.f)));
        const float f1 = __frcp_rn(1.f + exp2_f(fminf(s1[i], 115.f)));
        s0[i] = (ka < qpos) ? f0 : 1.f;
        s1[i] = (kb2 < qpos) ? f1 : 1.f;
      }
      float gs[2][4], pg[2][4];
#pragma unroll
      for (int g = 0; g < 4; ++g) {
        gs[0][g] = (s0[4 * g] * s0[4 * g + 1]) * (s0[4 * g + 2] * s0[4 * g + 3]);
        gs[1][g] = (s1[4 * g] * s1[4 * g + 1]) * (s1[4 * g + 2] * s1[4 * g + 3]);
      }
#pragma unroll
      for (int kb = 0; kb < 2; ++kb)
#pragma unroll
        for (int g = 0; g < 4; ++g) pg[kb][g] = __shfl_xor(gs[kb][g], 32);
      float run = carry;
#pragma unroll
      for (int kb = 1; kb >= 0; --kb)
#pragma unroll
        for (int g = 3; g >= 0; --g) {
          const float after = run * (h == 0 ? pg[kb][g] : 1.f);
          f32x16& sx = kb ? s1 : s0;
          const float a3 = after, a2 = a3 * sx[4 * g + 3], a1 = a2 * sx[4 * g + 2], a0 = a1 * sx[4 * g + 1], am = a0 * sx[4 * g];
          sx[4 * g + 3] = a3 - a2; sx[4 * g + 2] = a2 - a1; sx[4 * g + 1] = a1 - a0; sx[4 * g] = a0 - am;
          run *= gs[kb][g] * pg[kb][g];
        }
      carry = run;
      if (__all(carry == 0.f) && lane == 0) sDone[wave] = 1;
    } else {
      if (TYPE == 1) {
#pragma unroll
        for (int i = 0; i < 16; ++i) { s0[i] += cq - sC[crow(i, h)]; s1[i] += cq - sC[32 + crow(i, h)]; }
      }
      if (key0 + 63 > q0 + wave * 32) {
#pragma unroll
        for (int i = 0; i < 16; ++i) {
          const int ka = key0 + crow(i, h), kb2 = ka + 32;
          s0[i] = ka <= qpos ? s0[i] : -INFINITY;
          s1[i] = kb2 <= qpos ? s1[i] : -INFINITY;
        }
      }
      softmax_step(s0, s1, m, l, o);
    }
    pv_tile(sV, s0, s1, o, r, h);
  }
  float rowscale = 1.f;
  if (TYPE != 0) { const float lt = l + __shfl_xor(l, 32); rowscale = lt > 0.f ? 1.f / lt : 0.f; }
  store_mix(p, o, rowscale, (int)tq, col0, h);
}

DI void attn_nsa_item(const P& p, int b, int q0, char* smem) {
  unsigned* hbc = (unsigned*)(smem + AOFF_HB);
  u16* sK = (u16*)smem;
  u16* sV = (u16*)(smem + 25600);
  float* bufA = (float*)smem;
  float* bufB = bufA + 4 * 32 * 33;
  float* impF = bufB + 4 * 32 * 33;
  unsigned* qmask = (unsigned*)(smem + 25600 + 18432 + 256);
  constexpr int KLD = 136;
  const int tid = vtid(), wave = tid >> 6, lane = tid & 63, r = lane & 31, h = lane >> 5;
  const int qpos = q0 + r;
  const long tq = (long)b * S_ + qpos;
  const int cur = q0 >> 6;
  bf16x8 qf[8];
  {
    const u16* Qp = ((u16*)(p.ws + OFF_NQ)) + tq * 512 + wave * 128;
#pragma unroll
    for (int st = 0; st < 8; ++st) qf[st] = *(const bf16x8*)(Qp + st * 16 + h * 8);
  }
  const float gc = ((float*)(p.ws + OFF_BR))[tq * 12 + wave * 3 + 0], gsl = ((float*)(p.ws + OFF_BR))[tq * 12 + wave * 3 + 1], gw = ((float*)(p.ws + OFF_BR))[tq * 12 + wave * 3 + 2];
  float* Fp = ((float*)(p.ws + OFF_FN)) + tq * 512 + wave * 128;
  f32x16 o[4];
  KStage<16> ks; VStage vs;
  if (tid < 32) qmask[tid] = 0u;
  {
    const u16* KCb = ((u16*)(p.ws + OFF_KC)) + (long)b * 128 * 128;
    const u16* VCb = ((u16*)(p.ws + OFF_VCt)) + (long)b * 128 * 128;
    const bool two = q0 >= 1024;
    f32x16 sa0, sa1, sb0, sb1;
    k_fetch<16>(ks, KCb, 128, nullptr, 0);
    hbar(hbc);
    k_commit<16, KLD>(ks, sK);
    hbar(hbc);
    if (two) k_fetch<16>(ks, KCb + 64 * 128, 128, nullptr, 0);
    qk_tile<8, KLD>(sK, qf, sa0, sa1, r, h);
    if (two) {
      hbar(hbc);
      k_commit<16, KLD>(ks, sK);
      hbar(hbc);
      qk_tile<8, KLD>(sK, qf, sb0, sb1, r, h);
    } else {
#pragma unroll
      for (int i = 0; i < 16; ++i) { sb0[i] = -INFINITY; sb1[i] = -INFINITY; }
    }
    float tm = -INFINITY;
#pragma unroll
    for (int i = 0; i < 16; ++i) {
      const int n0 = crow(i, h);
      sa0[i] = (16 * n0 + 31 <= qpos) ? sa0[i] : -INFINITY;
      sa1[i] = (16 * (n0 + 32) + 31 <= qpos) ? sa1[i] : -INFINITY;
      sb0[i] = (16 * (n0 + 64) + 31 <= qpos) ? sb0[i] : -INFINITY;
      sb1[i] = ((n0 + 96) <= 126 && 16 * (n0 + 96) + 31 <= qpos) ? sb1[i] : -INFINITY;
      tm = fmaxf(tm, fmaxf(fmaxf(sa0[i], sa1[i]), fmaxf(sb0[i], sb1[i])));
    }
    tm = fmaxf(tm, __shfl_xor(tm, 32));
    const float mu = (tm == -INFINITY) ? 0.f : tm;
    float ps = 0.f;
#pragma unroll
    for (int i = 0; i < 16; ++i) {
      sa0[i] = exp2_f(sa0[i] - mu); sa1[i] = exp2_f(sa1[i] - mu); sb0[i] = exp2_f(sb0[i] - mu); sb1[i] = exp2_f(sb1[i] - mu);
      ps += (sa0[i] + sa1[i]) + (sb0[i] + sb1[i]);
    }
    ps += __shfl_xor(ps, 32);
    const float inv = ps > 0.f ? 1.f / ps : 0.f;
#pragma unroll
    for (int i = 0; i < 16; ++i) { sa0[i] *= inv; sa1[i] *= inv; sb0[i] *= inv; sb1[i] *= inv; }
    hbar(hbc);
#pragma unroll
    for (int tt = 0; tt < 2; ++tt)
#pragma unroll
      for (int kb = 0; kb < 2; ++kb) {
        const f32x16& pc = tt ? (kb ? sb1 : sb0) : (kb ? sa1 : sa0);
#pragma unroll
        for (int g = 0; g < 4; ++g) {
          const int s = 16 * tt + 8 * kb + 2 * g + h;
          bufA[(wave * 32 + r) * 33 + s] = (pc[4 * g] + pc[4 * g + 1]) + (pc[4 * g + 2] + 0.5f * pc[4 * g + 3]);
          if (s + 1 < 32) bufB[(wave * 32 + r) * 33 + s + 1] = 0.5f * pc[4 * g + 3];
        }
      }
    hbar(hbc);
    {
      const int q = tid >> 3, sub = tid & 7;
#pragma unroll
      for (int c = 0; c < 4; ++c) {
        const int s = sub * 4 + c;
        float a = 0.f;
#pragma unroll
        for (int w = 0; w < 4; ++w) a += bufA[(w * 32 + q) * 33 + s] + (s > 0 ? bufB[(w * 32 + q) * 33 + s] : 0.f);
        impF[q * 33 + s] = a;
      }
    }
    hbar(hbc);
    {
      const int q = tid >> 3, sub = tid & 7;
      unsigned bits = 0u;
      if (cur + 1 <= 16) {
        if (sub == 0) bits = (cur + 1 >= 32) ? 0xffffffffu : ((1u << (cur + 1)) - 1u);
      } else {
#pragma unroll
        for (int c = 0; c < 4; ++c) {
          const int s = sub * 4 + c;
          if (s > cur) continue;
          const bool forced = (s == 0) || (s == cur) || (s == cur - 1);
          if (forced) { bits |= 1u << s; continue; }
          const float v = impF[q * 33 + s];
          int rank = 0;
          for (int s2 = 1; s2 < cur - 1; ++s2) {
            const float v2 = impF[q * 33 + s2];
            rank += (v2 > v || (v2 == v && s2 < s)) ? 1 : 0;
          }
          if (rank < 13) bits |= 1u << s;
        }
      }
      if (bits) atomicOr(&qmask[q], bits);
    }
    hbar(hbc);
#pragma unroll
    for (int db = 0; db < 4; ++db) o[db] = zero16();
    v_fetch(vs, VCb, 128);
    v_commit(vs, sV);
    hbar(hbc);
    if (two) v_fetch(vs, VCb + 64, 128);
    pv_tile(sV, sa0, sa1, o, r, h);
    if (two) {
      hbar(hbc);
      v_commit(vs, sV);
      hbar(hbc);
      pv_tile(sV, sb0, sb1, o, r, h);
    }
#pragma unroll
    for (int db = 0; db < 4; ++db)
#pragma unroll
      for (int g = 0; g < 4; ++g) {
        f32x4 v; v[0] = o[db][4 * g] * gc; v[1] = o[db][4 * g + 1] * gc; v[2] = o[db][4 * g + 2] * gc; v[3] = o[db][4 * g + 3] * gc;
        *(f32x4*)&Fp[db * 32 + 8 * g + 4 * h] = v;
      }
  }
  const unsigned mybits = qmask[r];
  for (int br = 0; br < 2; ++br) {
    const u16* Kb = (br ? ((u16*)(p.ws + OFF_KWIN)) : ((u16*)(p.ws + OFF_KSEL))) + (long)b * S_ * 128;
    const u16* Vb = (br ? ((u16*)(p.ws + OFF_VWINt)) : ((u16*)(p.ws + OFF_VSELt))) + (long)b * 128 * S_;
    const int tlo = br ? ((q0 > 511 ? q0 - 511 : 0) >> 6) : 0;
    const int thi = cur;
#pragma unroll
    for (int db = 0; db < 4; ++db) o[db] = zero16();
    float m = -INFINITY, l = 0.f;
    k_fetch<16>(ks, Kb + (long)thi * 64 * 128, 128, nullptr, 0);
    v_fetch(vs, Vb + thi * 64, S_);
    hbar(hbc);
    k_commit<16, KLD>(ks, (u16*)smem);
    v_commit(vs, (u16*)(smem + AOFF_V0));
    if (thi > tlo) {
      k_fetch<16>(ks, Kb + (long)(thi - 1) * 64 * 128, 128, nullptr, 0);
      v_fetch(vs, Vb + (thi - 1) * 64, S_);
    }
    hbar(hbc);
    int cur = 0;
    for (int t = thi; t >= tlo; --t) {
      const u16* sKc = (const u16*)(smem + cur * AOFF_K1); const u16* sVc = (const u16*)(smem + AOFF_V0 + cur * (AOFF_V1 - AOFF_V0));
      u16* sKn = (u16*)(smem + (cur ^ 1) * AOFF_K1); u16* sVn = (u16*)(smem + AOFF_V0 + (cur ^ 1) * (AOFF_V1 - AOFF_V0));
      const int key0 = t * 64;
      f32x16 s0, s1;
      qk_tile<8, KLD>(sKc, qf, s0, s1, r, h);
      if (t > tlo) k_commit<16, KLD>(ks, sKn);
      const bool sel = br ? true : ((mybits >> t) & 1u);
      const bool interior = (key0 + 63 <= q0) && (br ? (key0 > q0 + 31 - 512) : (bool)__all(sel));
      if (!interior) {
#pragma unroll
        for (int i = 0; i < 16; ++i) {
          const int ka = key0 + crow(i, h), kb2 = ka + 32;
          bool v0 = sel && ka <= qpos, v1 = sel && kb2 <= qpos;
          if (br) { v0 = v0 && (ka > qpos - 512); v1 = v1 && (kb2 > qpos - 512); }
          s0[i] = v0 ? s0[i] : -INFINITY;
          s1[i] = v1 ? s1[i] : -INFINITY;
        }
      }
      softmax_step(s0, s1, m, l, o);
      if (t > tlo) {
        v_commit(vs, sVn);
        if (t - 1 > tlo) {
          k_fetch<16>(ks, Kb + (long)(t - 2) * 64 * 128, 128, nullptr, 0);
          v_fetch(vs, Vb + (t - 2) * 64, S_);
        }
      }
      pv_tile(sVc, s0, s1, o, r, h);
      hbar(hbc);
      cur ^= 1;
    }
    const float lt = l + __shfl_xor(l, 32);
    const float sc = (lt > 0.f ? 1.f / lt : 0.f) * (br ? gw : gsl);
    if (br == 0) {
#pragma unroll
      for (int db = 0; db < 4; ++db)
#pragma unroll
        for (int g = 0; g < 4; ++g) {
          f32x4 v = *(f32x4*)&Fp[db * 32 + 8 * g + 4 * h];
          v[0] += o[db][4 * g] * sc; v[1] += o[db][4 * g + 1] * sc; v[2] += o[db][4 * g + 2] * sc; v[3] += o[db][4 * g + 3] * sc;
          *(f32x4*)&Fp[db * 32 + 8 * g + 4 * h] = v;
        }
    } else {
#pragma unroll
      for (int db = 0; db < 4; ++db)
#pragma unroll
        for (int g = 0; g < 4; ++g) {
          const f32x4 v = *(f32x4*)&Fp[db * 32 + 8 * g + 4 * h];
          o[db][4 * g] = o[db][4 * g] * sc + v[0]; o[db][4 * g + 1] = o[db][4 * g + 1] * sc + v[1];
          o[db][4 * g + 2] = o[db][4 * g + 2] * sc + v[2]; o[db][4 * g + 3] = o[db][4 * g + 3] * sc + v[3];
        }
      store_mix(p, o, 1.f, (int)tq, 512 + wave * 128, h);
    }
  }
}

DI void phase_att(const P& p, int qidx, unsigned xcc, char* smem) {
  const int half = vhalf();
  char* hs = smem + half * HALF_BYTES;
  unsigned* hbc = (unsigned*)(hs + AOFF_HB);
  int* sItem = (int*)(hs + AOFF_ITEM);
  unsigned* ctr = ((unsigned*)(p.ws + OFF_ctr)) + XB_CTR + qidx * 8;
  __syncthreads();
  if (vtid() == 0) *hbc = 0u;
  __syncthreads();
  for (;;) {
    hbar(hbc);
    if (vtid() == 0) {
      int item = -1, qx = 0;
      for (int v = 0; v < 8; ++v) {
        const int xx = (int)((xcc + (unsigned)v) & 7u);
        if (xb_ld(&ctr[xx]) < 128u) {
          const unsigned got = atomicAdd(&ctr[xx], 1u);
          if (got < 128u) { item = (int)got; qx = xx; break; }
        }
      }
      sItem[0] = item; sItem[1] = qx;
    }
    hbar(hbc);
    const int li = sItem[0], x = sItem[1];
    if (li < 0) break;
    const int qb = 15 - (li >> 3), k = li & 7;
    if (k < 2) attn_causal_item<2>(p, 2 * x + k, qb, hs);
    else if (k < 4) attn_causal_item<1>(p, 2 * x + (k - 2), qb, hs);
    else if (k < 6) attn_causal_item<0>(p, 2 * x + (k - 4), qb, hs);
    else attn_nsa_item(p, x >> 1, qb * 128 + ((x & 1) * 2 + (k - 6)) * 32, hs);
  }
}

DI void phase_g2(const P& p, int layer, char* smem) {
  const u16* Wt = ((u16*)(p.ws + OFF_wt_out)) + (long)layer * D_ * D_;
  constexpr int TOT = 32 * 8;
  for (int t = blockIdx.x; t < TOT; t += gridDim.x) {
    const int xcd = t & 7, j = t >> 3;
    const int mt = xcd * 4 + (j & 3), tnb = j >> 2;
    const int m0 = mt * 256, n0 = tnb * 256;
    const u16* A = ((u16*)(p.ws + OFF_MIX)) + (long)m0 * D_;
    auto epi = [&](f32x16 (&acc)[4][2], int wr, int wc, int r, int h) {
#pragma unroll
      for (int i = 0; i < 4; ++i)
#pragma unroll
        for (int jj = 0; jj < 2; ++jj)
#pragma unroll
          for (int e = 0; e < 16; ++e) {
            const int m = m0 + wr * 128 + i * 32 + crow(e, h);
            ((u16*)(p.ws + OFF_Y))[(long)m * D_ + n0 + wc * 64 + jj * 32 + r] = f2bf(acc[i][jj][e]);
          }
    };
    gemm_tile<2, 4, 4, 2, 64, 512>(smem, A, D_, Wt + (long)n0 * D_, D_, D_, epi);
  }
}

DI void phase_norm(const P& p, int layer) {
  const int tid = vtid();
  const bool last = layer == 1;
  for (int it = blockIdx.x; it < T_ / 8; it += gridDim.x) {
    const int row = it * 8 + (opaque_tid() >> 6);
    norm_row(p, row, 1, layer == 0 ? p.x : ((float*)(p.ws + OFF_X1)), ((u16*)(p.ws + OFF_Y)), p.post_g + layer * D_, last ? p.out : ((float*)(p.ws + OFF_X1)),
             last ? nullptr : p.pre_g + (layer + 1) * D_, ((u16*)(p.ws + OFF_H)));
  }
}

__global__ void __launch_bounds__(NTHREADS, 2) hybrid_megakernel(P p) {
  __shared__ __attribute__((aligned(16))) char smem[SMEM_BYTES];
  __shared__ __attribute__((aligned(16))) unsigned xbst[4];
  unsigned* bar = (unsigned*)(p.ws + OFF_ctr);
  const unsigned xcc = xb_xcc_id();
  if (threadIdx.x == 0) { xbst[0] = 0u; xbst[1] = 0u; (void)xb_add(&bar[XB_XCNT(xcc)], 1u); }
  __syncthreads();
  for (int ph = p.phase_lo; ph < p.phase_hi; ++ph) {
    if (ph > p.phase_lo) {
      if (p.phase_lo < 0) cg::this_grid().sync();
      xcd_barrier(bar, xcc, xbst);
    }
    if (ph == 0) {
      phase0(p, smem);
#if DUP_SUB == 9
      xcd_barrier(bar, xcc, xbst); phase0(p, smem);
#endif
      continue;
    }
    const int layer = (ph - 1) / 5, sub = (ph - 1) % 5;
    for (int rep = 0; rep < (sub == DUP_SUB ? 2 : 1); ++rep) {
      if (rep) xcd_barrier(bar, xcc, xbst);
      if (sub == 0) phase_g1(p, layer, smem);
      else if (sub == 1) phase_prep(p, layer, smem);
      else if (sub == 2) phase_att(p, layer + 2 * rep, xcc, smem);
      else if (sub == 3) phase_g2(p, layer, smem);
      else phase_norm(p, layer);
    }
  }
}

extern "C" void kernel_launch(void* const* d_in, const int* in_sizes, int n_in, void* d_out, int out_size, void* d_ws, size_t ws_size,
                              hipStream_t stream) {
  static int grid_blocks = 0;
  if (!grid_blocks) {
    int dev = 0, cus = 0, per_cu = 0;
    hipGetDevice(&dev);
    hipDeviceGetAttribute(&cus, hipDeviceAttributeMultiprocessorCount, dev);
    hipOccupancyMaxActiveBlocksPerMultiprocessor(&per_cu, hybrid_megakernel, NTHREADS, 0);
    if (per_cu > 1) per_cu = 1;
    if (per_cu < 1) per_cu = 1;
    grid_blocks = cus * per_cu;
  }
  P p{};
  p.x = (const float*)d_in[0]; p.pre_g = (const float*)d_in[1]; p.post_g = (const float*)d_in[2]; p.w_in = (const float*)d_in[3];
  p.b_in = (const float*)d_in[4]; p.w_out = (const float*)d_in[5]; p.fb = (const float*)d_in[6]; p.pos_k = (const float*)d_in[7];
  p.w1_k = (const float*)d_in[8]; p.w2_k = (const float*)d_in[9]; p.pos_v = (const float*)d_in[10]; p.w1_v = (const float*)d_in[11];
  p.w2_v = (const float*)d_in[12]; p.qn_g = (const float*)d_in[13]; p.w_uq = (const float*)d_in[14]; p.kvn_g = (const float*)d_in[15];
  p.w_ukv = (const float*)d_in[16];
  p.out = (float*)d_out;
  p.ws = (char*)d_ws;
  p.phase_lo = 0; p.phase_hi = 11;
  hipMemsetAsync((char*)d_ws + OFF_ctr, 0, XCD_BAR_WORDS * sizeof(unsigned), stream);
  void* args[] = {&p};
  hipError_t e = hipLaunchCooperativeKernel((void*)hybrid_megakernel, dim3(grid_blocks), dim3(NTHREADS), args, 0, stream);
  if (e != hipSuccess) fprintf(stderr, "cooperative launch failed: %s (grid %d)\n", hipGetErrorString(e), grid_blocks);
}
```

```cpp
#include <hip/hip_runtime.h>
#include <hip/hip_cooperative_groups.h>
#include <cstdio>
namespace cg = cooperative_groups;

typedef unsigned short u16;
typedef short bf16x8 __attribute__((ext_vector_type(8)));
typedef float f32x16 __attribute__((ext_vector_type(16)));
typedef float f32x4 __attribute__((ext_vector_type(4)));
typedef float f32x2 __attribute__((ext_vector_type(2)));
typedef unsigned u32x4 __attribute__((ext_vector_type(4)));
typedef unsigned u32x2 __attribute__((ext_vector_type(2)));
typedef __bf16 bf16x2_t __attribute__((ext_vector_type(2)));

#define DI __device__ __forceinline__

constexpr int S_ = 2048;
constexpr int T_ = 8192;
constexpr int D_ = 2048;
constexpr int NINO = 6992;
constexpr int NINP = 7040;
constexpr int NTHREADS = 512;
constexpr int VT = 256;
constexpr int HALF_BYTES = 73728;
constexpr int AOFF_K1 = 17408, AOFF_V0 = 34816, AOFF_V1 = 53248, AOFF_C = 71680, AOFF_QM = 72192, AOFF_HB = 72448, AOFF_ITEM = 72512, AOFF_DONE = 72576;
constexpr int VLD = 72;
constexpr int SMEM_BYTES = 2 * 512 * 72 * 2 + 2048;
constexpr int SH_OFF = 2 * 512 * 72 * 2 + 1024;
#ifndef DUP_SUB
#define DUP_SUB -1
#endif

struct P {
  const float *x, *pre_g, *post_g, *w_in, *b_in, *w_out, *fb, *pos_k, *w1_k, *w2_k, *pos_v, *w1_v, *w2_v, *qn_g, *w_uq, *kvn_g, *w_ukv;
  float* out;
  char* ws;
  int phase_lo, phase_hi;
};
constexpr size_t OFF_wt_in = 0ull;
constexpr size_t OFF_wt_out = 57671680ull;
constexpr size_t OFF_w1t = 74448896ull;
constexpr size_t OFF_w2t = 78643200ull;
constexpr size_t OFF_wuqt = 78774272ull;
constexpr size_t OFF_wukvt = 79953920ull;
constexpr size_t OFF_c1part = 80478208ull;
constexpr size_t OFF_bperm = 80543744ull;
constexpr size_t OFF_ropec = 80600064ull;
constexpr size_t OFF_ropes = 81124352ull;
constexpr size_t OFF_H = 81648640ull;
constexpr size_t OFF_X1 = 115203072ull;
constexpr size_t OFF_Y = 182311936ull;
constexpr size_t OFF_SBQ = 249420800ull;
constexpr size_t OFF_SBK = 257809408ull;
constexpr size_t OFF_SBVt = 266198016ull;
constexpr size_t OFF_NQ = 274586624ull;
constexpr size_t OFF_KCT = 282975232ull;
constexpr size_t OFF_VCT = 285137920ull;
constexpr size_t OFF_KSEL = 287300608ull;
constexpr size_t OFF_VSELt = 289397760ull;
constexpr size_t OFF_KWIN = 291494912ull;
constexpr size_t OFF_VWINt = 293592064ull;
constexpr size_t OFF_FQ = 295689216ull;
constexpr size_t OFF_FK = 304077824ull;
constexpr size_t OFF_FVt = 312466432ull;
constexpr size_t OFF_CQ = 320855040ull;
constexpr size_t OFF_CKV = 327146496ull;
constexpr size_t OFF_KR = 329243648ull;
constexpr size_t OFF_G = 330292224ull;
constexpr size_t OFF_MQ = 363846656ull;
constexpr size_t OFF_MKN = 376429568ull;
constexpr size_t OFF_MVt = 384818176ull;
constexpr size_t OFF_KC = 393206784ull;
constexpr size_t OFF_VCt = 393337856ull;
constexpr size_t OFF_MIX = 393468928ull;
constexpr size_t OFF_BR = 427023360ull;
constexpr size_t OFF_LOGF = 427416576ull;
constexpr size_t OFF_CUM = 427547648ull;
constexpr size_t OFF_FN = 427678720ull;
constexpr size_t OFF_ctr = 444455936ull;
constexpr size_t OFF_PART = OFF_ctr + 65536;
constexpr size_t WS_TOTAL_OLD = 444456192ull;


DI unsigned pk2(float a, float b) { f32x2 v = {a, b}; bf16x2_t r = __builtin_convertvector(v, bf16x2_t); return __builtin_bit_cast(unsigned, r); }
DI u16 f2bf(float a) { return (u16)(pk2(a, 0.f) & 0xffffu); }
DI float bf2f(u16 v) { return __uint_as_float(((unsigned)v) << 16); }
DI f32x16 mfma(bf16x8 a, bf16x8 b, f32x16 c) { return __builtin_amdgcn_mfma_f32_32x32x16_bf16(a, b, c, 0, 0, 0); }
DI int crow(int i, int h) { return (i & 3) + 8 * (i >> 2) + 4 * h; }
DI bf16x8 pack8(const f32x16& x, int s) {
  u32x4 p;
  p[0] = pk2(x[8 * s + 0], x[8 * s + 1]); p[1] = pk2(x[8 * s + 2], x[8 * s + 3]);
  p[2] = pk2(x[8 * s + 4], x[8 * s + 5]); p[3] = pk2(x[8 * s + 6], x[8 * s + 7]);
  return __builtin_bit_cast(bf16x8, p);
}
DI float silu_f(float v) { return v * __frcp_rn(1.f + __expf(-v)); }
DI float sigmoid_f(float v) { return 1.f / (1.f + __expf(-v)); }
DI float logsigmoid_f(float v) { return fminf(v, 0.f) - log1pf(__expf(-fabsf(v))); }
DI int opaque_tid() { int t = threadIdx.x; asm volatile("" : "+v"(t)); return t; }
DI int vtid() { return opaque_tid() & (VT - 1); }
DI int vhalf() { return __builtin_amdgcn_readfirstlane(opaque_tid() >> 8); }
template <class T> DI T* opq(T* q) { asm volatile("" : "+s"(q)); return q; }
DI float logsigmoid_fast(float v) { return fminf(v, 0.f) - __logf(1.f + __expf(-fabsf(v))); }
DI float exp2_f(float v) { return __builtin_amdgcn_exp2f(v); }
DI f32x16 zero16() { f32x16 z; for (int i = 0; i < 16; ++i) z[i] = 0.f; return z; }


#define XB_TMO      128
#define XB_XCNT(j)  (256  + 64 * (j))
#define XB_XSUB(j)  (1280 + 64 * (j))
#define XB_XGEN(j)  (2304 + 64 * (j))
#define XB_TOP      3328
#define XB_TOPGEN   3392
#define XB_CTR      3456
#define XB_CMPCNT   3520
#define XCD_BAR_WORDS 3584
#define XB_SPIN_CAP (1u << 20)
DI unsigned xb_ld(unsigned* q) { return __hip_atomic_load(q, __ATOMIC_RELAXED, __HIP_MEMORY_SCOPE_AGENT); }
DI unsigned xb_add(unsigned* q, unsigned v) { return __hip_atomic_fetch_add(q, v, __ATOMIC_RELAXED, __HIP_MEMORY_SCOPE_AGENT); }
DI unsigned xb_xcc_id() { return (unsigned)__builtin_amdgcn_s_getreg((3 << 11) | 20) & 0xFu; }
#define XB_SPIN(cond, bar) do { unsigned _sp = 0; while (cond) { __builtin_amdgcn_s_sleep(1); \
    if ((++_sp & 255u) == 0u) { if (xb_ld(&(bar)[XB_TMO])) break; if (_sp > XB_SPIN_CAP) { atomicAdd(&(bar)[XB_TMO], 1u); break; } } } } while (0)
DI void xcd_barrier_complete(unsigned* bar, unsigned x, unsigned& nloc, unsigned& nx) {
  const unsigned G = gridDim.x;
  unsigned sum, cnt, mine, sp = 0u;
  for (;;) {
    sum = 0u; cnt = 0u; mine = 0u;
#pragma unroll
    for (unsigned j = 0; j < 16; ++j) { const unsigned c = xb_ld(&bar[XB_XCNT(j)]); sum += c; cnt += (c > 0u) ? 1u : 0u; mine = (j == x) ? c : mine; }
    if (sum == G) break;
    __builtin_amdgcn_s_sleep(1);
    if ((++sp & 255u) == 0u) { if (xb_ld(&bar[XB_TMO])) break; if (sp > XB_SPIN_CAP) { atomicAdd(&bar[XB_TMO], 1u); break; } }
  }
  nloc = mine > 0u ? mine : 1u; nx = cnt > 0u ? cnt : 1u;
}
DI void xcd_barrier(unsigned* bar, unsigned x, volatile unsigned* st) {
  asm volatile("s_waitcnt vmcnt(0)" ::: "memory");
  __syncthreads();
  if (threadIdx.x == 0) {
    __builtin_amdgcn_s_waitcnt(0);
    unsigned nloc = st[0], nx = st[1];
    if (nloc == 0u) { xcd_barrier_complete(bar, x, nloc, nx); st[0] = nloc; st[1] = nx; }
    const unsigned old = xb_add(&bar[XB_XSUB(x)], 1u);
    const unsigned gen = old / nloc;
    if (old + 1u == (gen + 1u) * nloc) {
      __builtin_amdgcn_fence(__ATOMIC_RELEASE, "agent");
      asm volatile("s_waitcnt vmcnt(0)" ::: "memory");
      const unsigned og = xb_add(&bar[XB_TOP], 1u);
      const unsigned tg = og / nx;
      if (og + 1u == (tg + 1u) * nx) xb_add(&bar[XB_TOPGEN], 1u);
      else XB_SPIN(xb_ld(&bar[XB_TOPGEN]) == tg, bar);
      __builtin_amdgcn_fence(__ATOMIC_ACQUIRE, "agent");
      xb_add(&bar[XB_XGEN(x)], 1u);
      asm volatile("s_waitcnt vmcnt(0)" ::: "memory");
    } else {
      XB_SPIN(xb_ld(&bar[XB_XGEN(x)]) == gen, bar);
      __builtin_amdgcn_fence(__ATOMIC_ACQUIRE, "agent");
      asm volatile("s_waitcnt vmcnt(0)" ::: "memory");
    }
  }
  __syncthreads();
}

DI void hbar(unsigned* cnt) {
  asm volatile("s_waitcnt lgkmcnt(0)" ::: "memory");
  unsigned old = 0;
  if ((opaque_tid() & 63) == 0) old = __hip_atomic_fetch_add(cnt, 1u, __ATOMIC_RELAXED, __HIP_MEMORY_SCOPE_WORKGROUP);
  old = (unsigned)__builtin_amdgcn_readfirstlane((int)old);
  const unsigned target = (old / 4u + 1u) * 4u;
  while (__hip_atomic_load(cnt, __ATOMIC_RELAXED, __HIP_MEMORY_SCOPE_WORKGROUP) < target) __builtin_amdgcn_s_sleep(1);
  asm volatile("s_waitcnt lgkmcnt(0)" ::: "memory");
}

DI int ropeperm(int j) { return ((j >> 5) & 1) * 64 + (j >> 6) * 32 + (j & 31); }
DI int incol(int np) {
  const int tn = np >> 7, j = np & 127;
  if (tn < 16) return np;
  if (tn < 20) return 2048 + (tn - 16) * 128 + ropeperm(j);
  if (tn == 20) return 2560 + j;
  if (tn == 21) return 2688 + j;
  if (tn == 22) return 2816 + ropeperm(j);
  if (tn == 23) return 2944 + j;
  if (tn == 24) return 3072 + ropeperm(j);
  if (tn == 25) return 3200 + j;
  if (tn < 30) return 3340 + (tn - 26) * 128 + j;
  if (tn < 42) return 3852 + (tn - 30) * 128 + j;
  if (tn < 46) return 5392 + (tn - 42) * 128 + j;
  if (tn < 50) return 5904 + (tn - 46) * 128 + j;
  if (tn < 54) return 6480 + (tn - 50) * 128 + j;
  if (j < 64) return 6416 + j;
  if (j < 76) return 3328 + (j - 64);
  if (j < 80) return 5388 + (j - 76);
  return -1;
}
DI int colmap(int kind, int np) {
  if (kind == 0) return np;
  if (kind == 1) return incol(np);
  const int tn = np >> 7, j = np & 127;
  if (kind == 2) { if (tn < 4) return tn * 192 + j; const int hd = (tn - 4) * 2 + (j >> 6); return hd * 192 + 128 + (j & 63); }
  if (tn < 4) return tn * 256 + j;
  return (tn - 4) * 256 + 128 + j;
}

DI void tconv(float* sT, const float* __restrict__ src, int ldsrc, u16* __restrict__ dst, int lddst, int k0, int n0, int kind, const float* __restrict__ gk) {
  const int tid = vtid();
  const int c4 = (tid & 15) * 4, rr = tid >> 4;
  const int sc = colmap(kind, n0 + c4);
  f32x4 v[4];
#pragma unroll
  for (int i = 0; i < 4; ++i) {
    const int k = rr + 16 * i;
    if (sc >= 0) v[i] = *(const f32x4*)&src[(long)(k0 + k) * ldsrc + sc];
    else { v[i][0] = 0.f; v[i][1] = 0.f; v[i][2] = 0.f; v[i][3] = 0.f; }
  }
#pragma unroll
  for (int i = 0; i < 4; ++i) {
    const int k = rr + 16 * i;
    const float g = gk ? gk[k0 + k] : 1.f;
    sT[k * 65 + c4 + 0] = v[i][0] * g; sT[k * 65 + c4 + 1] = v[i][1] * g; sT[k * 65 + c4 + 2] = v[i][2] * g; sT[k * 65 + c4 + 3] = v[i][3] * g;
  }
  __syncthreads();
  const int k2 = (tid & 31) * 2, n = tid >> 5;
#pragma unroll
  for (int i = 0; i < 8; ++i) {
    const int nn = n + 8 * i;
    *(unsigned*)&dst[(long)(n0 + nn) * lddst + k0 + k2] = pk2(sT[k2 * 65 + nn], sT[(k2 + 1) * 65 + nn]);
  }
  __syncthreads();
}

DI void tconv_load(f32x4 (&v)[4], const float* __restrict__ src, int ldsrc, int k0, int n0, int kind) {
  const int tid = vtid();
  const int c4 = (tid & 15) * 4, rr = tid >> 4;
  const int sc = colmap(kind, n0 + c4);
#pragma unroll
  for (int i = 0; i < 4; ++i) {
    const int k = rr + 16 * i;
    if (sc >= 0) v[i] = *(const f32x4*)&src[(long)(k0 + k) * ldsrc + sc];
    else { v[i][0] = 0.f; v[i][1] = 0.f; v[i][2] = 0.f; v[i][3] = 0.f; }
  }
}
DI void tconv_lds(float* sT, const f32x4 (&v)[4]) {
  const int tid = vtid();
  const int c4 = (tid & 15) * 4, rr = tid >> 4;
#pragma unroll
  for (int i = 0; i < 4; ++i) {
    const int k = rr + 16 * i;
    sT[k * 65 + c4 + 0] = v[i][0]; sT[k * 65 + c4 + 1] = v[i][1]; sT[k * 65 + c4 + 2] = v[i][2]; sT[k * 65 + c4 + 3] = v[i][3];
  }
}
DI void tconv_out(const float* sT, u16* __restrict__ dst, int lddst, int k0, int n0) {
  const int tid = vtid();
  const int k2 = (tid & 31) * 2, n = tid >> 5;
#pragma unroll
  for (int i = 0; i < 8; ++i) {
    const int nn = n + 8 * i;
    *(unsigned*)&dst[(long)(n0 + nn) * lddst + k0 + k2] = pk2(sT[k2 * 65 + nn], sT[(k2 + 1) * 65 + nn]);
  }
}
DI void bigw_desc(const P& p, int it, const float*& src, int& ldsrc, u16*& dst, int& k0, int& n0, int& kind) {
  if (it < 7040) {
    const int l = it / 3520, r = it % 3520; const int nt = r >> 5, kt = r & 31;
    src = p.w_in + (long)l * D_ * NINO; ldsrc = NINO; dst = ((u16*)(p.ws + OFF_wt_in)) + (long)l * NINP * D_; k0 = kt * 64; n0 = nt * 64; kind = 1;
  } else {
    const int i2 = it - 7040; const int l = i2 >> 10, r = i2 & 1023; const int nt = r >> 5, kt = r & 31;
    src = p.w_out + (long)l * D_ * D_; ldsrc = D_; dst = ((u16*)(p.ws + OFF_wt_out)) + (long)l * D_ * D_; k0 = kt * 64; n0 = nt * 64; kind = 0;
  }
}

DI void norm_row(const P& p, int row, int mode, const float* __restrict__ xprev, const u16* __restrict__ y, const float* __restrict__ postg,
                 float* __restrict__ xout, const float* __restrict__ preg, u16* __restrict__ hout) {
  const int lane = vtid() & 63;
  f32x4 xv[8];
  const long base = (long)row * D_;
#pragma unroll
  for (int j = 0; j < 8; ++j) xv[j] = *(const f32x4*)&xprev[base + (j * 64 + lane) * 4];
  if (mode == 1) {
    f32x4 yv[8];
    float ss = 0.f;
#pragma unroll
    for (int j = 0; j < 8; ++j) { const u32x2 yb = *(const u32x2*)&y[base + (j * 64 + lane) * 4]; yv[j][0] = __uint_as_float(yb[0] << 16); yv[j][1] = __uint_as_float(yb[0] & 0xffff0000u); yv[j][2] = __uint_as_float(yb[1] << 16); yv[j][3] = __uint_as_float(yb[1] & 0xffff0000u); ss += yv[j][0] * yv[j][0] + yv[j][1] * yv[j][1] + yv[j][2] * yv[j][2] + yv[j][3] * yv[j][3]; }
#pragma unroll
    for (int o = 32; o > 0; o >>= 1) ss += __shfl_xor(ss, o);
    const float rs = rsqrtf(ss * (1.f / D_) + 1e-6f);
#pragma unroll
    for (int j = 0; j < 8; ++j) {
      const f32x4 g = *(const f32x4*)&postg[(j * 64 + lane) * 4];
      xv[j][0] += yv[j][0] * rs * g[0]; xv[j][1] += yv[j][1] * rs * g[1]; xv[j][2] += yv[j][2] * rs * g[2]; xv[j][3] += yv[j][3] * rs * g[3];
      *(f32x4*)&xout[base + (j * 64 + lane) * 4] = xv[j];
    }
  }
  if (preg) {
    float ss = 0.f;
#pragma unroll
    for (int j = 0; j < 8; ++j) ss += xv[j][0] * xv[j][0] + xv[j][1] * xv[j][1] + xv[j][2] * xv[j][2] + xv[j][3] * xv[j][3];
#pragma unroll
    for (int o = 32; o > 0; o >>= 1) ss += __shfl_xor(ss, o);
    const float rs = rsqrtf(ss * (1.f / D_) + 1e-6f);
#pragma unroll
    for (int j = 0; j < 8; ++j) {
      const f32x4 g = *(const f32x4*)&preg[(j * 64 + lane) * 4];
      u32x2 o2; o2[0] = pk2(xv[j][0] * rs * g[0], xv[j][1] * rs * g[1]); o2[1] = pk2(xv[j][2] * rs * g[2], xv[j][3] * rs * g[3]);
      *(u32x2*)&hout[base + (j * 64 + lane) * 4] = o2;
    }
  }
}

DI void phase0(const P& p, char* smem) {
  const int half = vhalf();
  float* sT = (float*)(smem + half * HALF_BYTES);
  const int tid = vtid();
  const int vb = (int)blockIdx.x * 2 + half, vg = (int)gridDim.x * 2;
  constexpr int nA = 7040, nB = 2048, nC = 512, nD = 16, nE = 144, nF = 64;
  constexpr int oB = nA, oC = oB + nB, oD = oC + nC, oE = oD + nD, oF = oE + nE, oG = oF + nF;
  constexpr int nG = 56, nH = 128, nI = 512, nK = 2048;
  constexpr int oH = oG + nG, oI = oH + nH, oK = oI + nI, total = oK + nK;
  {
    int it = vb;
    f32x4 v[4];
    const float* src; int ldsrc; u16* dst; int k0, n0, kind;
    if (it < oC) { bigw_desc(p, it, src, ldsrc, dst, k0, n0, kind); tconv_load(v, src, ldsrc, k0, n0, kind); }
    while (it < oC) {
      tconv_lds(sT, v);
      __syncthreads();
      const int nxt = it + vg;
      const float* src2 = src; int ldsrc2 = ldsrc; u16* dst2 = dst; int k02 = k0, n02 = n0, kind2 = kind;
      if (nxt < oC) { bigw_desc(p, nxt, src2, ldsrc2, dst2, k02, n02, kind2); tconv_load(v, src2, ldsrc2, k02, n02, kind2); }
      tconv_out(sT, dst, D_, k0, n0);
      __syncthreads();
      it = nxt; src = src2; ldsrc = ldsrc2; dst = dst2; k0 = k02; n0 = n02; kind = kind2;
    }
  }
  for (int it = oC + vb; it < total; it += vg) {
    if (it < oB) {
      const int l = it / 3520, r = it % 3520; const int nt = r >> 5, kt = r & 31;
      tconv(sT, p.w_in + (long)l * D_ * NINO, NINO, ((u16*)(p.ws + OFF_wt_in)) + (long)l * NINP * D_, D_, kt * 64, nt * 64, 1, nullptr);
    } else if (it < oC) {
      const int i2 = it - oB; const int l = i2 >> 10, r = i2 & 1023; const int nt = r >> 5, kt = r & 31;
      tconv(sT, p.w_out + (long)l * D_ * D_, D_, ((u16*)(p.ws + OFF_wt_out)) + (long)l * D_ * D_, D_, kt * 64, nt * 64, 0, nullptr);
    } else if (it < oD) {
      const int i2 = it - oC; const int ls = i2 >> 7, r = i2 & 127; const int nt = r >> 6, kt = r & 63;
      const float* src = ((ls & 1) ? p.w1_v : p.w1_k) + (long)(ls >> 1) * 4096 * 128;
      tconv(sT, src, 128, ((u16*)(p.ws + OFF_w1t)) + (long)ls * 128 * 4096, 4096, kt * 64, nt * 64, 0, nullptr);
    } else if (it < oE) {
      const int i2 = it - oD; const int ls = i2 >> 2, r = i2 & 3; const int nt = r >> 1, kt = r & 1;
      const float* src = ((ls & 1) ? p.w2_v : p.w2_k) + (long)(ls >> 1) * 128 * 128;
      tconv(sT, src, 128, ((u16*)(p.ws + OFF_w2t)) + (long)ls * 128 * 128, 128, kt * 64, nt * 64, 0, nullptr);
    } else if (it < oF) {
      const int i2 = it - oE; const int l = i2 / 72, r = i2 % 72; const int nt = r / 6, kt = r % 6;
      tconv(sT, p.w_uq + (long)l * 384 * 768, 768, ((u16*)(p.ws + OFF_wuqt)) + (long)l * 768 * 384, 384, kt * 64, nt * 64, 2, p.qn_g + l * 384);
    } else if (it < oG) {
      const int i2 = it - oF; const int l = i2 >> 5, r = i2 & 31; const int nt = r >> 1, kt = r & 1;
      tconv(sT, p.w_ukv + (long)l * 128 * 1024, 1024, ((u16*)(p.ws + OFF_wukvt)) + (long)l * 1024 * 128, 128, kt * 64, nt * 64, 3, p.kvn_g + l * 128);
    } else if (it < oH) {
      const int i2 = it - oG;
      const int idx = i2 * 256 + tid;
      if (idx < 2 * NINP) { const int l = idx / NINP, np = idx % NINP; const int sc = incol(np); ((float*)(p.ws + OFF_bperm))[idx] = sc >= 0 ? p.b_in[l * NINO + sc] : 0.f; }
    } else if (it < oI) {
      const int i2 = it - oH; const int ls = i2 >> 5, c = i2 & 31;
      const float* w1 = ((ls & 1) ? p.w1_v : p.w1_k) + (long)(ls >> 1) * 4096 * 128;
      const float* pe = ((ls & 1) ? p.pos_v : p.pos_k) + (long)(ls >> 1) * 4096;
      const int n = tid & 127, hf = tid >> 7;
      float a = 0.f;
#pragma unroll 8
      for (int i = 0; i < 64; ++i) { const int k = c * 128 + hf * 64 + i; a += pe[k] * w1[(long)k * 128 + n]; }
      sT[tid] = a;
      __syncthreads();
      if (tid < 128) ((float*)(p.ws + OFF_c1part))[(ls * 32 + c) * 128 + tid] = sT[tid] + sT[tid + 128];
      __syncthreads();
    } else if (it < oK) {
      const int idx = (it - oI) * 256 + tid; const int pos = idx >> 6, f = idx & 63;
      const float inv = powf(10000.f, -(float)f / 64.f);
      const float ang = (float)pos * inv;
      float sn, cs; sincosf(ang, &sn, &cs);
      ((float*)(p.ws + OFF_ropec))[idx] = cs; ((float*)(p.ws + OFF_ropes))[idx] = sn;
    } else {
      const int row = (it - oK) * 4 + (tid >> 6);
      norm_row(p, row, 0, p.x, nullptr, nullptr, nullptr, p.pre_g, ((u16*)(p.ws + OFF_H)));
    }
  }
}

template <int WR, int WC, int RB, int CB, int GBK, int NT, class Epi>
DI void gemm_tile(char* smem, const u16* __restrict__ A, int lda, const u16* __restrict__ Bt, int ldb, int K, Epi epi) {
  constexpr int BM = WR * RB * 32, BN = WC * CB * 32;
  constexpr int GLD = GBK + 8;
  constexpr int CPR = GBK / 8;
  constexpr int RPP = NT / CPR;
  constexpr int NA = BM / RPP, NB = BN / RPP;
  constexpr bool DB = (NT == 512);
  constexpr int STAGE = (BM + BN) * GLD;
  u16* sbase = (u16*)smem;
  const int tid = opaque_tid() & (NT - 1), wave = tid >> 6, lane = tid & 63, r = lane & 31, h = lane >> 5;
  const int wr = wave / WC, wc = wave % WC;
  f32x16 acc[RB][CB];
#pragma unroll
  for (int i = 0; i < RB; ++i)
#pragma unroll
    for (int j = 0; j < CB; ++j) acc[i][j] = zero16();
  u32x4 ra[NA], rb[NB];
  const unsigned trow = (unsigned)tid / CPR, tcol = ((unsigned)tid % CPR) * 8;
  const unsigned voffA = (trow * (unsigned)lda + tcol) * 2u, voffB = (trow * (unsigned)ldb + tcol) * 2u;
  const unsigned soff = (trow * GLD + tcol) * 2u;
#pragma unroll
  for (int i = 0; i < NA; ++i) ra[i] = *(const u32x4*)((const char*)(A + (long)i * RPP * lda) + voffA);
#pragma unroll
  for (int i = 0; i < NB; ++i) rb[i] = *(const u32x4*)((const char*)(Bt + (long)i * RPP * ldb) + voffB);
  if (DB) {
    __syncthreads();
#pragma unroll
    for (int i = 0; i < NA; ++i) *(u32x4*)((char*)sbase + i * RPP * GLD * 2 + soff) = ra[i];
#pragma unroll
    for (int i = 0; i < NB; ++i) *(u32x4*)((char*)(sbase + BM * GLD) + i * RPP * GLD * 2 + soff) = rb[i];
    {
      const int k1 = GBK < K ? GBK : 0;
#pragma unroll
      for (int i = 0; i < NA; ++i) ra[i] = *(const u32x4*)((const char*)(A + (long)i * RPP * lda + k1) + voffA);
#pragma unroll
      for (int i = 0; i < NB; ++i) rb[i] = *(const u32x4*)((const char*)(Bt + (long)i * RPP * ldb + k1) + voffB);
    }
    __syncthreads();
  }
  int cur = 0;
  for (int k0 = 0; k0 < K; k0 += GBK) {
    u16* sA = sbase + (DB ? cur * STAGE : 0);
    u16* sB = sA + BM * GLD;
    u16* nA = sbase + (cur ^ 1) * STAGE;
    const int kn2 = (k0 + 2 * GBK < K) ? k0 + 2 * GBK : K - GBK;
    if (!DB) {
      __syncthreads();
#pragma unroll
      for (int i = 0; i < NA; ++i) *(u32x4*)((char*)sA + i * RPP * GLD * 2 + soff) = ra[i];
#pragma unroll
      for (int i = 0; i < NB; ++i) *(u32x4*)((char*)sB + i * RPP * GLD * 2 + soff) = rb[i];
      __syncthreads();
      if (k0 + GBK < K) {
#pragma unroll
        for (int i = 0; i < NA; ++i) ra[i] = *(const u32x4*)((const char*)(A + (long)i * RPP * lda + k0 + GBK) + voffA);
#pragma unroll
        for (int i = 0; i < NB; ++i) rb[i] = *(const u32x4*)((const char*)(Bt + (long)i * RPP * ldb + k0 + GBK) + voffB);
      }
    }
    {
      bf16x8 af[2][RB], bfr[2][CB];
#pragma unroll
      for (int i = 0; i < RB; ++i) af[0][i] = *(const bf16x8*)&sA[((wr * RB + i) * 32 + r) * GLD + h * 8];
#pragma unroll
      for (int j = 0; j < CB; ++j) bfr[0][j] = *(const bf16x8*)&sB[((wc * CB + j) * 32 + r) * GLD + h * 8];
#pragma unroll
      for (int ks = 0; ks < GBK / 16; ++ks) {
        if (ks + 1 < GBK / 16) {
#pragma unroll
          for (int i = 0; i < RB; ++i) af[(ks + 1) & 1][i] = *(const bf16x8*)&sA[((wr * RB + i) * 32 + r) * GLD + (ks + 1) * 16 + h * 8];
#pragma unroll
          for (int j = 0; j < CB; ++j) bfr[(ks + 1) & 1][j] = *(const bf16x8*)&sB[((wc * CB + j) * 32 + r) * GLD + (ks + 1) * 16 + h * 8];
        }
#pragma unroll
        for (int i = 0; i < RB; ++i)
#pragma unroll
          for (int j = 0; j < CB; ++j) acc[i][j] = mfma(af[ks & 1][i], bfr[ks & 1][j], acc[i][j]);
        if (DB) {
          if (ks < NA) { *(u32x4*)((char*)nA + ks * RPP * GLD * 2 + soff) = ra[ks]; ra[ks] = *(const u32x4*)((const char*)(A + (long)ks * RPP * lda + kn2) + voffA); }
          if (ks < NB) { *(u32x4*)((char*)(nA + BM * GLD) + ks * RPP * GLD * 2 + soff) = rb[ks]; rb[ks] = *(const u32x4*)((const char*)(Bt + (long)ks * RPP * ldb + kn2) + voffB); }
        }
        if (ks + 1 < GBK / 16) __builtin_amdgcn_sched_group_barrier(0x100, RB + CB, 0);
        __builtin_amdgcn_sched_group_barrier(0x008, RB * CB, 0);
      }
    }
    if (DB) { __syncthreads(); cur ^= 1; }
  }
  epi(acc, wr, wc, r, h);
}

DI void store_vt(const f32x16& a, u16* __restrict__ dst  ) {
#pragma unroll
  for (int s = 0; s < 2; ++s) {
    u32x4 v; v[0] = pk2(a[8 * s], a[8 * s + 1]); v[1] = pk2(a[8 * s + 2], a[8 * s + 3]); v[2] = pk2(a[8 * s + 4], a[8 * s + 5]); v[3] = pk2(a[8 * s + 6], a[8 * s + 7]);
    *(u32x4*)(dst + 16 * s) = v;
  }
}

template <int RB>
DI void g1_epilogue(const P& p, int layer, f32x16 (&acc)[RB][2], int m0, int tn, int cbase, int rowbase, int r, int h) {
  if (tn > 54) return;
  const float* bias = ((float*)(p.ws + OFF_bperm)) + layer * NINP + tn * 128 + cbase;
  const int b = m0 >> 11, sb0 = m0 & 2047;
#pragma unroll
  for (int jj = 0; jj < 2; ++jj) {
    const float bv = bias[jj * 32 + r];
#pragma unroll
    for (int i = 0; i < RB; ++i)
#pragma unroll
      for (int e = 0; e < 16; ++e) acc[i][jj][e] += bv;
  }
  int kind; u16* dst = nullptr; int ld = 0, coloff = 0; float scale = 1.f; int nh = 1, hd = 0;
  const float qs = 0.08838834764831845f * 1.4426950408889634f;
  if (tn < 4) { kind = 0; dst = ((u16*)(p.ws + OFF_SBQ)); ld = 512; coloff = tn * 128; scale = qs; }
  else if (tn < 8) { kind = 0; dst = ((u16*)(p.ws + OFF_SBK)); ld = 512; coloff = (tn - 4) * 128; }
  else if (tn < 12) { kind = 2; dst = ((u16*)(p.ws + OFF_SBVt)); nh = 4; hd = tn - 8; }
  else if (tn < 16) { kind = 3; coloff = (tn - 12) * 128; }
  else if (tn < 20) { kind = 1; dst = ((u16*)(p.ws + OFF_NQ)); ld = 512; coloff = (tn - 16) * 128; scale = qs; }
  else if (tn == 20) { kind = 0; dst = ((u16*)(p.ws + OFF_KCT)); ld = 128; }
  else if (tn == 21) { kind = 0; dst = ((u16*)(p.ws + OFF_VCT)); ld = 128; }
  else if (tn == 22) { kind = 1; dst = ((u16*)(p.ws + OFF_KSEL)); ld = 128; }
  else if (tn == 23) { kind = 2; dst = ((u16*)(p.ws + OFF_VSELt)); }
  else if (tn == 24) { kind = 1; dst = ((u16*)(p.ws + OFF_KWIN)); ld = 128; }
  else if (tn == 25) { kind = 2; dst = ((u16*)(p.ws + OFF_VWINt)); }
  else if (tn < 30) { kind = 3; coloff = 512 + (tn - 26) * 128; }
  else if (tn < 34) { kind = 0; dst = ((u16*)(p.ws + OFF_FQ)); ld = 512; coloff = (tn - 30) * 128; scale = qs; }
  else if (tn < 38) { kind = 0; dst = ((u16*)(p.ws + OFF_FK)); ld = 512; coloff = (tn - 34) * 128; }
  else if (tn < 42) { kind = 2; dst = ((u16*)(p.ws + OFF_FVt)); nh = 4; hd = tn - 38; }
  else if (tn < 46) { kind = 3; coloff = 1024 + (tn - 42) * 128; }
  else if (tn < 49) { kind = 0; dst = ((u16*)(p.ws + OFF_CQ)); ld = 384; coloff = (tn - 46) * 128; }
  else if (tn == 49) { kind = 0; dst = ((u16*)(p.ws + OFF_CKV)); ld = 128; }
  else if (tn < 54) { kind = 3; coloff = 1536 + (tn - 50) * 128; }
  else kind = 4;
  if (kind == 3) { kind = 0; dst = ((u16*)(p.ws + OFF_G)); ld = 2048; scale = 0.f; }
  if (kind == 0) {
#pragma unroll
    for (int i = 0; i < RB; ++i)
#pragma unroll
      for (int jj = 0; jj < 2; ++jj)
#pragma unroll
        for (int e = 0; e < 16; ++e) {
          const int m = m0 + rowbase + i * 32 + crow(e, h);
          const float v = acc[i][jj][e];
          dst[(long)m * ld + coloff + cbase + jj * 32 + r] = f2bf(scale == 0.f ? silu_f(v) : v * scale);
        }
  } else if (kind == 1) {
    const int f = (cbase >> 6) * 32 + r;
#pragma unroll
    for (int i = 0; i < RB; ++i)
#pragma unroll
      for (int e = 0; e < 16; ++e) {
        const int m = m0 + rowbase + i * 32 + crow(e, h);
        const int pos = m & 2047;
        const float cs = ((float*)(p.ws + OFF_ropec))[pos * 64 + f], sn = ((float*)(p.ws + OFF_ropes))[pos * 64 + f];
        const float x1 = acc[i][0][e], x2 = acc[i][1][e];
        dst[(long)m * ld + coloff + f] = f2bf((x1 * cs - x2 * sn) * scale);
        dst[(long)m * ld + coloff + 64 + f] = f2bf((x2 * cs + x1 * sn) * scale);
      }
  } else if (kind == 2) {
#pragma unroll
    for (int i = 0; i < RB; ++i)
#pragma unroll
      for (int jj = 0; jj < 2; ++jj) {
        const int d = cbase + jj * 32 + r;
        u16* o = dst + ((long)((b * nh + hd) * 128 + d)) * S_ + sb0 + rowbase + i * 32 + 8 * h;
        store_vt(acc[i][jj], o);
      }
  } else {
    const float* fbias = p.fb + layer * 4;
    if (cbase == 0) {
#pragma unroll
      for (int i = 0; i < RB; ++i)
#pragma unroll
        for (int e = 0; e < 16; ++e) {
          const int m = m0 + rowbase + i * 32 + crow(e, h);
          const int pos = m & 2047;
          const float cs = ((float*)(p.ws + OFF_ropec))[pos * 64 + 2 * r], sn = ((float*)(p.ws + OFF_ropes))[pos * 64 + 2 * r];
          const float x1 = acc[i][0][e], x2 = acc[i][1][e];
          ((u16*)(p.ws + OFF_KR))[(long)m * 64 + r] = f2bf(x1 * cs - x2 * sn);
          ((u16*)(p.ws + OFF_KR))[(long)m * 64 + 32 + r] = f2bf(x2 * cs + x1 * sn);
        }
    } else {
      if (r < 16) {
        const float fbv = r >= 12 ? fbias[r - 12] : 0.f;
#pragma unroll
        for (int i = 0; i < RB; ++i)
#pragma unroll
          for (int e = 0; e < 16; ++e) {
            const int m = m0 + rowbase + i * 32 + crow(e, h);
            const float v = acc[i][0][e];
            if (r < 12) ((float*)(p.ws + OFF_BR))[(long)m * 12 + r] = sigmoid_f(v);
            else ((float*)(p.ws + OFF_LOGF))[(long)m * 4 + (r - 12)] = logsigmoid_f(v + fbv);
          }
      }
    }
  }
}

DI void phase_g1(const P& p, int layer, char* smem) {
  const u16* Wt = ((u16*)(p.ws + OFF_wt_in)) + (long)layer * NINP * D_;
  constexpr int NBIG = 32 * 24, NSMALL = 32 * 7;
  for (int t = blockIdx.x; t < NBIG + NSMALL; t += gridDim.x) {
    if (t < NBIG) {
      const int xcd = t & 7, j = t >> 3;
      const int mt = xcd * 4 + (j & 3), tnb = j >> 2;
      const int m0 = mt * 256, n0 = tnb * 256;
      auto epi = [&](f32x16 (&acc)[4][2], int wr, int wc, int r, int h) { g1_epilogue<4>(p, layer, acc, m0, tnb * 2 + (wc >> 1), (wc & 1) * 64, wr * 128, r, h); };
      gemm_tile<2, 4, 4, 2, 64, 512>(smem, ((u16*)(p.ws + OFF_H)) + (long)m0 * D_, D_, Wt + (long)n0 * D_, D_, D_, epi);
    } else {
      const int t2 = t - NBIG;
      const int xcd = t2 & 7, j = t2 >> 3;
      const int mt = xcd * 4 + (j & 3), tn = 48 + (j >> 2);
      const int m0 = mt * 256, n0 = tn * 128;
      auto epi = [&](f32x16 (&acc)[2][2], int wr, int wc, int r, int h) { g1_epilogue<2>(p, layer, acc, m0, tn, wc * 64, wr * 64, r, h); };
      gemm_tile<4, 2, 2, 2, 64, 512>(smem, ((u16*)(p.ws + OFF_H)) + (long)m0 * D_, D_, Wt + (long)n0 * D_, D_, D_, epi);
    }
  }
}

DI void phase_prep(const P& p, int layer, char* smem) {
  float* sR = (float*)(smem + 2 * 512 * 72 * 2);
  constexpr int nCmp = 64, nCum = 8, nUQ = 32 * 3, nUKV = 32 * 4;
  int* sFlag = (int*)(smem + SH_OFF + 256);
  constexpr int oCum = nCmp, oUQ = oCum + nCum, oUKV = oUQ + nUQ, total = oUKV + nUKV;
  for (int it = blockIdx.x; it < total; it += gridDim.x) {
    const int tid = vtid(), half = vhalf();
    __syncthreads();
    if (it < oCum) {
      char* hs = smem + half * HALF_BYTES;
      const int kq = it & 3, grp = it >> 2;
      const int st = half, b = (grp >> 2) & 3, mt = grp & 3;
      const int ls = layer * 2 + st;
      const u16* tok = (st ? ((u16*)(p.ws + OFF_VCT)) : ((u16*)(p.ws + OFF_KCT))) + (long)b * S_ * 128;
      f32x16 hacc;
      auto epi1 = [&](f32x16 (&acc)[1][1], int wr, int wc, int r, int h) { hacc = acc[0][0]; };
      gemm_tile<1, 4, 1, 1, 128, 256>(hs, tok + (long)mt * 32 * 2048 + kq * 1024, 2048, ((u16*)(p.ws + OFF_w1t)) + (long)ls * 128 * 4096 + kq * 1024, 4096, 1024, epi1);
      {
        const int wave = tid >> 6, lane = tid & 63, r = lane & 31, h = lane >> 5;
        float* pgrp = ((float*)(p.ws + OFF_PART)) + (long)(grp * 2 + st) * 4 * 4096;
#pragma unroll
        for (int e = 0; e < 16; ++e) pgrp[kq * 4096 + crow(e, h) * 128 + wave * 32 + r] = hacc[e];
        asm volatile("s_waitcnt vmcnt(0)" ::: "memory");
        __syncthreads();
        if (opaque_tid() == 0) {
          __builtin_amdgcn_fence(__ATOMIC_RELEASE, "agent");
          asm volatile("s_waitcnt vmcnt(0)" ::: "memory");
          *sFlag = (int)xb_add(((unsigned*)(p.ws + OFF_ctr)) + XB_CMPCNT + layer * 16 + grp, 1u);
        }
        __syncthreads();
        if ((*sFlag & 3) != 3) continue;
        if (opaque_tid() == 0) {
          __builtin_amdgcn_fence(__ATOMIC_ACQUIRE, "agent");
          asm volatile("s_waitcnt vmcnt(0)" ::: "memory");
        }
        __syncthreads();
#pragma unroll
        for (int e = 0; e < 16; ++e) {
          const int o = crow(e, h) * 128 + wave * 32 + r;
          hacc[e] = (pgrp[o] + pgrp[4096 + o]) + (pgrp[2 * 4096 + o] + pgrp[3 * 4096 + o]);
        }
      }
      const int wave = tid >> 6, lane = tid & 63, r = lane & 31, h = lane >> 5;
      __syncthreads();
      u16* sH = (u16*)hs;
      float* sO = (float*)(hs + 16384);
      {
        const int col = wave * 32 + r;
        float c1 = 0.f;
        for (int c = 0; c < 32; ++c) c1 += ((float*)(p.ws + OFF_c1part))[(ls * 32 + c) * 128 + col];
#pragma unroll
        for (int e = 0; e < 16; ++e) sH[crow(e, h) * 136 + col] = f2bf(silu_f(hacc[e] + c1));
      }
      __syncthreads();
      {
        f32x16 o = zero16();
        const u16* w2 = ((u16*)(p.ws + OFF_w2t)) + (long)ls * 128 * 128;
#pragma unroll
        for (int ks = 0; ks < 8; ++ks) {
          const bf16x8 a = *(const bf16x8*)&sH[r * 136 + ks * 16 + h * 8];
          const bf16x8 bb = *(const bf16x8*)&w2[(wave * 32 + r) * 128 + ks * 16 + h * 8];
          o = mfma(a, bb, o);
        }
#pragma unroll
        for (int e = 0; e < 16; ++e) sO[crow(e, h) * 129 + wave * 32 + r] = o[e];
      }
      __syncthreads();
      if (st == 0) {
        for (int idx = tid; idx < 32 * 64; idx += VT) {
          const int row = idx >> 6, f = idx & 63; const int n = mt * 32 + row;
          float o1 = 0.f, o2 = 0.f;
          if (n < 127) {
            const int pos = 16 * n + 31;
            const float cs = ((float*)(p.ws + OFF_ropec))[pos * 64 + f], sn = ((float*)(p.ws + OFF_ropes))[pos * 64 + f];
            const float x1 = sO[row * 129 + f], x2 = sO[row * 129 + 64 + f];
            o1 = x1 * cs - x2 * sn; o2 = x2 * cs + x1 * sn;
          }
          ((u16*)(p.ws + OFF_KC))[((long)b * 128 + n) * 128 + f] = f2bf(o1);
          ((u16*)(p.ws + OFF_KC))[((long)b * 128 + n) * 128 + 64 + f] = f2bf(o2);
        }
      } else {
        for (int idx = tid; idx < 32 * 128; idx += VT) {
          const int d = idx >> 5, row = idx & 31; const int n = mt * 32 + row;
          const float v = n < 127 ? sO[row * 129 + d] : 0.f;
          const int m16 = n & 15; const int pp = (n & ~15) + 8 * ((m16 >> 2) & 1) + 4 * (m16 >> 3) + (m16 & 3);
          ((u16*)(p.ws + OFF_VCt))[((long)b * 128 + d) * 128 + pp] = f2bf(v);
        }
      }
    } else if (it < oUQ) {
      const int bh = (it - oCum) * 2 + half; const int b = bh >> 2, hh = bh & 3;
      if (tid < 64) {
        const float* lf = ((float*)(p.ws + OFF_LOGF)) + (long)b * S_ * 4 + hh;
        float v[32]; float run = 0.f;
#pragma unroll
        for (int i = 0; i < 32; ++i) { run += lf[(long)(tid * 32 + i) * 4]; v[i] = run; }
        float inc = run;
#pragma unroll
        for (int o = 1; o < 64; o <<= 1) { const float t2 = __shfl_up(inc, o); if (tid >= o) inc += t2; }
        const float excl = inc - run;
#pragma unroll
        for (int i = 0; i < 32; ++i) ((float*)(p.ws + OFF_CUM))[(long)bh * S_ + tid * 32 + i] = (v[i] + excl) * 1.4426950408889634f;
      }
    } else {
      const int rt = opaque_tid();
      const bool isq = it < oUKV;
      const int i2 = isq ? it - oUQ : it - oUKV;
      const int ntn = isq ? 3 : 4;
      const int mt = i2 / ntn, tnb = i2 % ntn;
      const int m0 = mt * 256, n0 = tnb * 256;
      const int K = isq ? 384 : 128;
      const u16* A = (isq ? ((u16*)(p.ws + OFF_CQ)) : ((u16*)(p.ws + OFF_CKV))) + (long)m0 * K;
      {
        const int row = rt >> 1, hf = rt & 1;
        const u16* ar = A + (long)row * K + hf * (K / 2);
        float ss = 0.f;
#pragma unroll 8
        for (int c = 0; c < K / 16; ++c) {
          const u32x4 v = *(const u32x4*)(ar + c * 8);
#pragma unroll
          for (int q = 0; q < 4; ++q) { const float lo = __uint_as_float(v[q] << 16), hi = __uint_as_float(v[q] & 0xffff0000u); ss += lo * lo + hi * hi; }
        }
        ss += __shfl_xor(ss, 1);
        if (hf == 0) sR[row] = rsqrtf(ss / (float)K + 1e-6f);
      }
      const u16* Bt = (isq ? ((u16*)(p.ws + OFF_wuqt)) + (long)layer * 768 * 384 : ((u16*)(p.ws + OFF_wukvt)) + (long)layer * 1024 * 128) + (long)n0 * K;
      auto epi = [&](f32x16 (&acc)[4][2], int wr, int wc, int r, int h) {
        const int b = m0 >> 11, sb0 = m0 & 2047;
        const int tn = tnb * 2 + (wc >> 1), cb = (wc & 1) * 64, rb0 = wr * 128;
        const float qs = 0.07216878364870322f * 1.4426950408889634f;
        if (isq) {
          if (tn < 4) {
#pragma unroll
            for (int i = 0; i < 4; ++i)
#pragma unroll
              for (int jj = 0; jj < 2; ++jj)
#pragma unroll
                for (int e = 0; e < 16; ++e) {
                  const int ml = rb0 + i * 32 + crow(e, h);
                  ((u16*)(p.ws + OFF_MQ))[(long)(m0 + ml) * 768 + tn * 192 + cb + jj * 32 + r] = f2bf(acc[i][jj][e] * sR[ml] * qs);
                }
          } else {
            const int hd = (tn - 4) * 2 + (wc & 1);
#pragma unroll
            for (int i = 0; i < 4; ++i)
#pragma unroll
              for (int e = 0; e < 16; ++e) {
                const int ml = rb0 + i * 32 + crow(e, h);
                const int pos = (m0 + ml) & 2047;
                const float cs = ((float*)(p.ws + OFF_ropec))[pos * 64 + 2 * r], sn = ((float*)(p.ws + OFF_ropes))[pos * 64 + 2 * r];
                const float sc = sR[ml] * qs;
                const float x1 = acc[i][0][e] * sc, x2 = acc[i][1][e] * sc;
                ((u16*)(p.ws + OFF_MQ))[(long)(m0 + ml) * 768 + hd * 192 + 128 + r] = f2bf(x1 * cs - x2 * sn);
                ((u16*)(p.ws + OFF_MQ))[(long)(m0 + ml) * 768 + hd * 192 + 160 + r] = f2bf(x2 * cs + x1 * sn);
              }
          }
        } else {
          if (tn < 4) {
#pragma unroll
            for (int i = 0; i < 4; ++i)
#pragma unroll
              for (int jj = 0; jj < 2; ++jj)
#pragma unroll
                for (int e = 0; e < 16; ++e) {
                  const int ml = rb0 + i * 32 + crow(e, h);
                  ((u16*)(p.ws + OFF_MKN))[(long)(m0 + ml) * 512 + tn * 128 + cb + jj * 32 + r] = f2bf(acc[i][jj][e] * sR[ml]);
                }
          } else {
            const int hd = tn - 4;
#pragma unroll
            for (int i = 0; i < 4; ++i)
#pragma unroll
              for (int jj = 0; jj < 2; ++jj) {
                f32x16 a = acc[i][jj];
#pragma unroll
                for (int e = 0; e < 16; ++e) a[e] *= sR[rb0 + i * 32 + crow(e, h)];
                const int d = cb + jj * 32 + r;
                u16* o = ((u16*)(p.ws + OFF_MVt)) + ((long)((b * 4 + hd) * 128 + d)) * S_ + sb0 + rb0 + i * 32 + 8 * h;
                store_vt(a, o);
              }
          }
        }
      };
      gemm_tile<2, 4, 4, 2, 64, 512>(smem, A, K, Bt, K, K, epi);
    }
  }
}

template <int NSTEP, int KLD>
DI void qk_tile(const u16* sK, const bf16x8 (&qf)[NSTEP], f32x16& s0, f32x16& s1, int r, int h, float init = 0.f) {
#pragma unroll
  for (int i = 0; i < 16; ++i) { s0[i] = init; s1[i] = init; }
#pragma unroll
  for (int st = 0; st < NSTEP; ++st) {
    const bf16x8 a0 = *(const bf16x8*)&sK[r * KLD + st * 16 + h * 8];
    const bf16x8 a1 = *(const bf16x8*)&sK[(32 + r) * KLD + st * 16 + h * 8];
    s0 = mfma(a0, qf[st], s0);
    s1 = mfma(a1, qf[st], s1);
  }
}
DI void pv_tile(const u16* sV, const f32x16& p0, const f32x16& p1, f32x16 (&o)[4], int r, int h) {
#pragma unroll
  for (int kb = 0; kb < 2; ++kb)
#pragma unroll
    for (int s = 0; s < 2; ++s) {
      const bf16x8 pb = pack8(kb ? p1 : p0, s);
#pragma unroll
      for (int db = 0; db < 4; ++db) {
        const bf16x8 a = *(const bf16x8*)&sV[(db * 32 + r) * VLD + kb * 32 + s * 16 + h * 8];
        o[db] = mfma(a, pb, o[db]);
      }
    }
}
DI void softmax_step(f32x16& s0, f32x16& s1, float& m, float& l, f32x16 (&o)[4]) {
  float tm = -INFINITY;
#pragma unroll
  for (int i = 0; i < 16; ++i) tm = fmaxf(tm, fmaxf(s0[i], s1[i]));
  tm = fmaxf(tm, __shfl_xor(tm, 32));
  const float mn = fmaxf(m, tm);
  const float mu = (mn == -INFINITY) ? 0.f : mn;
  float ps = 0.f;
#pragma unroll
  for (int i = 0; i < 16; ++i) { s0[i] = exp2_f(s0[i] - mu); s1[i] = exp2_f(s1[i] - mu); ps += s0[i] + s1[i]; }
  if (__any(mn != m)) {
    const float alpha = exp2_f(m - mu);
    l *= alpha;
#pragma unroll
    for (int db = 0; db < 4; ++db)
#pragma unroll
      for (int i = 0; i < 16; ++i) o[db][i] *= alpha;
  }
  l += ps;
  m = mn;
}

template <int NCH>
struct KStage { u32x4 v[NCH / 4]; };
template <int NCH>
DI void k_fetch(KStage<NCH>& st, const u16* __restrict__ k1, long ld1, const u16* __restrict__ k2, long ld2) {
  const int tid = vtid();
#pragma unroll
  for (int i = 0; i < NCH / 4; ++i) {
    const int c = tid + VT * i; const int row = c / NCH, ch = c % NCH;
    const u16* src = (NCH > 16 && ch >= 16) ? (k2 + (unsigned)(row * (int)ld2 + (ch - 16) * 8)) : (k1 + (unsigned)(row * (int)ld1 + ch * 8));
    st.v[i] = *(const u32x4*)src;
  }
}
template <int NCH, int KLD>
DI void k_commit(const KStage<NCH>& st, u16* sK) {
  const int tid = vtid();
#pragma unroll
  for (int i = 0; i < NCH / 4; ++i) {
    const int c = tid + VT * i; const int row = c / NCH, ch = c % NCH;
    *(u32x4*)&sK[row * KLD + ch * 8] = st.v[i];
  }
}
struct VStage { u32x4 v[4]; };
DI void v_fetch(VStage& st, const u16* __restrict__ vt, long ldv) {
  const int tid = vtid();
#pragma unroll
  for (int i = 0; i < 4; ++i) { const int c = tid + VT * i; st.v[i] = *(const u32x4*)(vt + (unsigned)((c >> 3) * (int)ldv + (c & 7) * 8)); }
}
DI void v_commit(const VStage& st, u16* sV) {
  const int tid = vtid();
#pragma unroll
  for (int i = 0; i < 4; ++i) { const int c = tid + VT * i; *(u32x4*)&sV[(c >> 3) * VLD + (c & 7) * 8] = st.v[i]; }
}

DI void store_mix(const P& p, const f32x16 (&o)[4], float rowscale, int t, int col0, int h) {
  asm volatile("" : "+v"(t));
  const long base = (long)t * 2048 + col0 + 4 * h;
  const u16* gp = ((u16*)(p.ws + OFF_G)) + base;
  u16* mp = ((u16*)(p.ws + OFF_MIX)) + base;
#pragma unroll
  for (int db = 0; db < 4; ++db)
#pragma unroll
    for (int g = 0; g < 4; ++g) {
      const int d = db * 32 + 8 * g;
      const u32x2 gv = *(const u32x2*)&gp[d];
      const float g0 = __uint_as_float(gv[0] << 16), g1 = __uint_as_float(gv[0] & 0xffff0000u);
      const float g2 = __uint_as_float(gv[1] << 16), g3 = __uint_as_float(gv[1] & 0xffff0000u);
      u32x2 ov;
      ov[0] = pk2(o[db][4 * g] * rowscale * g0, o[db][4 * g + 1] * rowscale * g1);
      ov[1] = pk2(o[db][4 * g + 2] * rowscale * g2, o[db][4 * g + 3] * rowscale * g3);
      *(u32x2*)&mp[d] = ov;
    }
}

template <int TYPE>
DI void attn_causal_item(const P& p, int bh, int qb, char* smem) {
  unsigned* hbc = (unsigned*)(smem + AOFF_HB);
  constexpr int NSTEP = TYPE == 2 ? 12 : 8;
  constexpr int NCH = TYPE == 2 ? 24 : 16;
  constexpr int KLD = TYPE == 2 ? 200 : 136;
  constexpr bool DBUF = TYPE != 2;
  u16* sK = (u16*)smem;
  u16* sV = (u16*)(smem + AOFF_V0);
  float* sC = (float*)(smem + AOFF_C);
  volatile int* sDone = (volatile int*)(smem + AOFF_DONE);
  const int tid = vtid(), wave = tid >> 6, lane = tid & 63, r = lane & 31, h = lane >> 5;
  const int b = bh >> 2, hd = bh & 3;
  const int q0 = qb * 128;
  const int qpos = q0 + wave * 32 + r;
  const long tq = (long)b * S_ + qpos;
  const u16* Qp; const u16* K1; long ld1; const u16* K2 = nullptr; long ld2 = 0; const u16* Vt;
  int col0;
  if (TYPE == 0) { Qp = ((u16*)(p.ws + OFF_SBQ)) + tq * 512 + hd * 128; K1 = ((u16*)(p.ws + OFF_SBK)) + (long)b * S_ * 512 + hd * 128; ld1 = 512; Vt = ((u16*)(p.ws + OFF_SBVt)) + (long)bh * 128 * S_; col0 = hd * 128; }
  else if (TYPE == 1) { Qp = ((u16*)(p.ws + OFF_FQ)) + tq * 512 + hd * 128; K1 = ((u16*)(p.ws + OFF_FK)) + (long)b * S_ * 512 + hd * 128; ld1 = 512; Vt = ((u16*)(p.ws + OFF_FVt)) + (long)bh * 128 * S_; col0 = 1024 + hd * 128; }
  else { Qp = ((u16*)(p.ws + OFF_MQ)) + tq * 768 + hd * 192; K1 = ((u16*)(p.ws + OFF_MKN)) + (long)b * S_ * 512 + hd * 128; ld1 = 512; K2 = ((u16*)(p.ws + OFF_KR)) + (long)b * S_ * 64; ld2 = 64; Vt = ((u16*)(p.ws + OFF_MVt)) + (long)bh * 128 * S_; col0 = 1536 + hd * 128; }
  bf16x8 qf[NSTEP];
#pragma unroll
  for (int st = 0; st < NSTEP; ++st) qf[st] = *(const bf16x8*)(Qp + st * 16 + h * 8);
  const float* cum = ((float*)(p.ws + OFF_CUM)) + (long)bh * S_;
  float cq = 0.f;
  if (TYPE == 1) cq = cum[qpos];
  f32x16 o[4];
#pragma unroll
  for (int db = 0; db < 4; ++db) o[db] = zero16();
  float m = -INFINITY, l = 0.f;
  float carry = 1.f;
  const int nt = 2 * qb + 2;
  KStage<NCH> ks; VStage vs; float cst = 0.f;
  {
    const int key0 = (nt - 1) * 64;
    k_fetch<NCH>(ks, K1 + (long)key0 * ld1, ld1, K2 + (long)key0 * ld2, ld2);
    v_fetch(vs, Vt + key0, S_);
    if (TYPE == 1 && tid < 64) cst = cum[key0 + tid];
  }
  const int qmax_w = q0 + wave * 32 + 31;
  if (TYPE == 0 && tid < 4) sDone[tid] = 0;
  if (DBUF) {
    hbar(hbc);
    k_commit<NCH, KLD>(ks, sK);
    v_commit(vs, sV);
    if (TYPE == 1 && tid < 64) sC[tid] = cst;
    if (nt > 1) {
      const int key0n = (nt - 2) * 64;
      k_fetch<NCH>(ks, K1 + (long)key0n * ld1, ld1, K2 + (long)key0n * ld2, ld2);
      v_fetch(vs, Vt + key0n, S_);
      if (TYPE == 1 && tid < 64) cst = cum[key0n + tid];
    }
    hbar(hbc);
    int cur = 0;
    for (int t = nt - 1; t >= 0; --t) {
      const int key0 = t * 64;
      const u16* sKc = (const u16*)(smem + cur * AOFF_K1); const u16* sVc = (const u16*)(smem + AOFF_V0 + cur * (AOFF_V1 - AOFF_V0)); const float* sCc = sC + cur * 64;
      u16* sKn = (u16*)(smem + (cur ^ 1) * AOFF_K1); u16* sVn = (u16*)(smem + AOFF_V0 + (cur ^ 1) * (AOFF_V1 - AOFF_V0));
      f32x16 s0, s1;
      qk_tile<NSTEP, KLD>(sKc, qf, s0, s1, r, h, TYPE == 1 ? cq : 0.f);
      if (t > 0) { k_commit<NCH, KLD>(ks, sKn); if (TYPE == 1 && tid < 64) sC[(cur ^ 1) * 64 + tid] = cst; }
      {
    if (TYPE == 0) {
#pragma unroll
        for (int i = 0; i < 16; ++i) {
          const int ka = key0 + crow(i, h), kb2 = ka + 32;
          const float f0 = __frcp_rn(1.f + exp2_f(fminf(s0[i], 115.f)));
          const float f1 = __frcp_rn(1.f + exp2_f(fminf(s1[i], 115.f)));
          s0[i] = (ka < qpos) ? f0 : 1.f;
          s1[i] = (kb2 < qpos) ? f1 : 1.f;
        }
        float gs[2][4], pg[2][4];
#pragma unroll
        for (int g = 0; g < 4; ++g) {
          gs[0][g] = (s0[4 * g] * s0[4 * g + 1]) * (s0[4 * g + 2] * s0[4 * g + 3]);
          gs[1][g] = (s1[4 * g] * s1[4 * g + 1]) * (s1[4 * g + 2] * s1[4 * g + 3]);
        }
#pragma unroll
        for (int kb = 0; kb < 2; ++kb)
#pragma unroll
          for (int g = 0; g < 4; ++g) pg[kb][g] = __shfl_xor(gs[kb][g], 32);
        float run = carry;
#pragma unroll
        for (int kb = 1; kb >= 0; --kb)
#pragma unroll
          for (int g = 3; g >= 0; --g) {
            const float after = run * (h == 0 ? pg[kb][g] : 1.f);
            f32x16& sx = kb ? s1 : s0;
            const float a3 = after, a2 = a3 * sx[4 * g + 3], a1 = a2 * sx[4 * g + 2], a0 = a1 * sx[4 * g + 1], am = a0 * sx[4 * g];
            sx[4 * g + 3] = a3 - a2; sx[4 * g + 2] = a2 - a1; sx[4 * g + 1] = a1 - a0; sx[4 * g] = a0 - am;
            run *= gs[kb][g] * pg[kb][g];
          }
        carry = run;
        if (__all(carry == 0.f) && lane == 0) sDone[wave] = 1;
      } else {
        if (TYPE == 1) {
#pragma unroll
          for (int i = 0; i < 16; ++i) { s0[i] -= sCc[crow(i, h)]; s1[i] -= sCc[32 + crow(i, h)]; }
        }
        if (key0 + 63 > q0 + wave * 32) {
#pragma unroll
          for (int i = 0; i < 16; ++i) {
            const int ka = key0 + crow(i, h), kb2 = ka + 32;
            s0[i] = ka <= qpos ? s0[i] : -INFINITY;
            s1[i] = kb2 <= qpos ? s1[i] : -INFINITY;
          }
        }
        softmax_step(s0, s1, m, l, o);
      }
      }
      if (t > 0) {
        v_commit(vs, sVn);
        if (t > 1) {
          const int key0n = (t - 2) * 64;
          k_fetch<NCH>(ks, K1 + (long)key0n * ld1, ld1, K2 + (long)key0n * ld2, ld2);
          v_fetch(vs, Vt + key0n, S_);
          if (TYPE == 1 && tid < 64) cst = cum[key0n + tid];
        }
      }
      pv_tile(sVc, s0, s1, o, r, h);
      hbar(hbc);
      cur ^= 1;
      if (TYPE == 0 && (sDone[0] & sDone[1] & sDone[2] & sDone[3])) break;
    }
  } else
  for (int t = nt - 1; t >= 0; --t) {
    hbar(hbc);
    if (TYPE == 0 && (sDone[0] & sDone[1] & sDone[2] & sDone[3])) break;
    k_commit<NCH, KLD>(ks, sK);
    v_commit(vs, sV);
    if (TYPE == 1 && tid < 64) sC[tid] = cst;
    hbar(hbc);
    if (t > 0) {
      const int key0n = (t - 1) * 64;
      k_fetch<NCH>(ks, K1 + (long)key0n * ld1, ld1, K2 + (long)key0n * ld2, ld2);
      v_fetch(vs, Vt + key0n, S_);
      if (TYPE == 1 && tid < 64) cst = cum[key0n + tid];
    }
    const int key0 = t * 64;
    if (key0 > qmax_w) continue;
    f32x16 s0, s1;
    qk_tile<NSTEP, KLD>(sK, qf, s0, s1, r, h);
    if (TYPE == 0) {
#pragma unroll
      for (int i = 0; i < 16; ++i) {
        const int ka = key0 + crow(i, h), kb2 = ka + 32;
        const float f0 = __frcp_rn(1.f + exp2_f(fminf(s0[i], 115.f)));
        const float f1 = __frcp_rn(1.f + exp2_f(fminf(s1[i], 115.f)));
        s0[i] = (ka < qpos) ? f0 : 1.f;
        s1[i] = (kb2 < qpos) ? f1 : 1.f;
      }
      float gs[2][4], pg[2][4];
#pragma unroll
      for (int g = 0; g < 4; ++g) {
        gs[0][g] = (s0[4 * g] * s0[4 * g + 1]) * (s0[4 * g + 2] * s0[4 * g + 3]);
        gs[1][g] = (s1[4 * g] * s1[4 * g + 1]) * (s1[4 * g + 2] * s1[4 * g + 3]);
      }
#pragma unroll
      for (int kb = 0; kb < 2; ++kb)
#pragma unroll
        for (int g = 0; g < 4; ++g) pg[kb][g] = __shfl_xor(gs[kb][g], 32);
      float run = carry;
#pragma unroll
      for (int kb = 1; kb >= 0; --kb)
#pragma unroll
        for (int g = 3; g >= 0; --g) {
          const float after = run * (h == 0 ? pg[kb][g] : 1.f);
          f32x16& sx = kb ? s1 : s0;
          const float a3 = after, a2 = a3 * sx[4 * g + 3], a1 = a2 * sx[4 * g + 2], a0 = a1 * sx[4 * g + 1], am = a0 * sx[4 * g];
          sx[4 * g + 3] = a3 - a2; sx[4 * g + 2] = a2 - a1; sx[4 * g + 1] = a1 - a0; sx[4 * g] = a0 - am;
          run *= gs[kb][g] * pg[kb][g];
        }
      carry = run;
      if (__all(carry == 0.f) && lane == 0) sDone[wave] = 1;
    } else {
      if (TYPE == 1) {
#pragma unroll
        for (int i = 0; i < 16; ++i) { s0[i] += cq - sC[crow(i, h)]; s1[i] += cq - sC[32 + crow(i, h)]; }
      }
      if (key0 + 63 > q0 + wave * 32) {
#pragma unroll
        for (int i = 0; i < 16; ++i) {
          const int ka = key0 + crow(i, h), kb2 = ka + 32;
          s0[i] = ka <= qpos ? s0[i] : -INFINITY;
          s1[i] = kb2 <= qpos ? s1[i] : -INFINITY;
        }
      }
      softmax_step(s0, s1, m, l, o);
    }
    pv_tile(sV, s0, s1, o, r, h);
  }
  float rowscale = 1.f;
  if (TYPE != 0) { const float lt = l + __shfl_xor(l, 32); rowscale = lt > 0.f ? 1.f / lt : 0.f; }
  store_mix(p, o, rowscale, (int)tq, col0, h);
}

DI void attn_nsa_item(const P& p, int b, int q0, char* smem) {
  unsigned* hbc = (unsigned*)(smem + AOFF_HB);
  u16* sK = (u16*)smem;
  u16* sV = (u16*)(smem + 25600);
  float* bufA = (float*)smem;
  float* bufB = bufA + 4 * 32 * 33;
  float* impF = bufB + 4 * 32 * 33;
  unsigned* qmask = (unsigned*)(smem + 25600 + 18432 + 256);
  constexpr int KLD = 136;
  const int tid = vtid(), wave = tid >> 6, lane = tid & 63, r = lane & 31, h = lane >> 5;
  const int qpos = q0 + r;
  const long tq = (long)b * S_ + qpos;
  const int cur = q0 >> 6;
  bf16x8 qf[8];
  {
    const u16* Qp = ((u16*)(p.ws + OFF_NQ)) + tq * 512 + wave * 128;
#pragma unroll
    for (int st = 0; st < 8; ++st) qf[st] = *(const bf16x8*)(Qp + st * 16 + h * 8);
  }
  const float gc = ((float*)(p.ws + OFF_BR))[tq * 12 + wave * 3 + 0], gsl = ((float*)(p.ws + OFF_BR))[tq * 12 + wave * 3 + 1], gw = ((float*)(p.ws + OFF_BR))[tq * 12 + wave * 3 + 2];
  float* Fp = ((float*)(p.ws + OFF_FN)) + tq * 512 + wave * 128;
  f32x16 o[4];
  KStage<16> ks; VStage vs;
  if (tid < 32) qmask[tid] = 0u;
  {
    const u16* KCb = ((u16*)(p.ws + OFF_KC)) + (long)b * 128 * 128;
    const u16* VCb = ((u16*)(p.ws + OFF_VCt)) + (long)b * 128 * 128;
    const bool two = q0 >= 1024;
    f32x16 sa0, sa1, sb0, sb1;
    k_fetch<16>(ks, KCb, 128, nullptr, 0);
    hbar(hbc);
    k_commit<16, KLD>(ks, sK);
    hbar(hbc);
    if (two) k_fetch<16>(ks, KCb + 64 * 128, 128, nullptr, 0);
    qk_tile<8, KLD>(sK, qf, sa0, sa1, r, h);
    if (two) {
      hbar(hbc);
      k_commit<16, KLD>(ks, sK);
      hbar(hbc);
      qk_tile<8, KLD>(sK, qf, sb0, sb1, r, h);
    } else {
#pragma unroll
      for (int i = 0; i < 16; ++i) { sb0[i] = -INFINITY; sb1[i] = -INFINITY; }
    }
    float tm = -INFINITY;
#pragma unroll
    for (int i = 0; i < 16; ++i) {
      const int n0 = crow(i, h);
      sa0[i] = (16 * n0 + 31 <= qpos) ? sa0[i] : -INFINITY;
      sa1[i] = (16 * (n0 + 32) + 31 <= qpos) ? sa1[i] : -INFINITY;
      sb0[i] = (16 * (n0 + 64) + 31 <= qpos) ? sb0[i] : -INFINITY;
      sb1[i] = ((n0 + 96) <= 126 && 16 * (n0 + 96) + 31 <= qpos) ? sb1[i] : -INFINITY;
      tm = fmaxf(tm, fmaxf(fmaxf(sa0[i], sa1[i]), fmaxf(sb0[i], sb1[i])));
    }
    tm = fmaxf(tm, __shfl_xor(tm, 32));
    const float mu = (tm == -INFINITY) ? 0.f : tm;
    float ps = 0.f;
#pragma unroll
    for (int i = 0; i < 16; ++i) {
      sa0[i] = exp2_f(sa0[i] - mu); sa1[i] = exp2_f(sa1[i] - mu); sb0[i] = exp2_f(sb0[i] - mu); sb1[i] = exp2_f(sb1[i] - mu);
      ps += (sa0[i] + sa1[i]) + (sb0[i] + sb1[i]);
    }
    ps += __shfl_xor(ps, 32);
    const float inv = ps > 0.f ? 1.f / ps : 0.f;
#pragma unroll
    for (int i = 0; i < 16; ++i) { sa0[i] *= inv; sa1[i] *= inv; sb0[i] *= inv; sb1[i] *= inv; }
    hbar(hbc);
#pragma unroll
    for (int tt = 0; tt < 2; ++tt)
#pragma unroll
      for (int kb = 0; kb < 2; ++kb) {
        const f32x16& pc = tt ? (kb ? sb1 : sb0) : (kb ? sa1 : sa0);
#pragma unroll
        for (int g = 0; g < 4; ++g) {
          const int s = 16 * tt + 8 * kb + 2 * g + h;
          bufA[(wave * 32 + r) * 33 + s] = (pc[4 * g] + pc[4 * g + 1]) + (pc[4 * g + 2] + 0.5f * pc[4 * g + 3]);
          if (s + 1 < 32) bufB[(wave * 32 + r) * 33 + s + 1] = 0.5f * pc[4 * g + 3];
        }
      }
    hbar(hbc);
    {
      const int q = tid >> 3, sub = tid & 7;
#pragma unroll
      for (int c = 0; c < 4; ++c) {
        const int s = sub * 4 + c;
        float a = 0.f;
#pragma unroll
        for (int w = 0; w < 4; ++w) a += bufA[(w * 32 + q) * 33 + s] + (s > 0 ? bufB[(w * 32 + q) * 33 + s] : 0.f);
        impF[q * 33 + s] = a;
      }
    }
    hbar(hbc);
    {
      const int q = tid >> 3, sub = tid & 7;
      unsigned bits = 0u;
      if (cur + 1 <= 16) {
        if (sub == 0) bits = (cur + 1 >= 32) ? 0xffffffffu : ((1u << (cur + 1)) - 1u);
      } else {
#pragma unroll
        for (int c = 0; c < 4; ++c) {
          const int s = sub * 4 + c;
          if (s > cur) continue;
          const bool forced = (s == 0) || (s == cur) || (s == cur - 1);
          if (forced) { bits |= 1u << s; continue; }
          const float v = impF[q * 33 + s];
          int rank = 0;
          for (int s2 = 1; s2 < cur - 1; ++s2) {
            const float v2 = impF[q * 33 + s2];
            rank += (v2 > v || (v2 == v && s2 < s)) ? 1 : 0;
          }
          if (rank < 13) bits |= 1u << s;
        }
      }
      if (bits) atomicOr(&qmask[q], bits);
    }
    hbar(hbc);
#pragma unroll
    for (int db = 0; db < 4; ++db) o[db] = zero16();
    v_fetch(vs, VCb, 128);
    v_commit(vs, sV);
    hbar(hbc);
    if (two) v_fetch(vs, VCb + 64, 128);
    pv_tile(sV, sa0, sa1, o, r, h);
    if (two) {
      hbar(hbc);
      v_commit(vs, sV);
      hbar(hbc);
      pv_tile(sV, sb0, sb1, o, r, h);
    }
#pragma unroll
    for (int db = 0; db < 4; ++db)
#pragma unroll
      for (int g = 0; g < 4; ++g) {
        f32x4 v; v[0] = o[db][4 * g] * gc; v[1] = o[db][4 * g + 1] * gc; v[2] = o[db][4 * g + 2] * gc; v[3] = o[db][4 * g + 3] * gc;
        *(f32x4*)&Fp[db * 32 + 8 * g + 4 * h] = v;
      }
  }
  const unsigned mybits = qmask[r];
  for (int br = 0; br < 2; ++br) {
    const u16* Kb = (br ? ((u16*)(p.ws + OFF_KWIN)) : ((u16*)(p.ws + OFF_KSEL))) + (long)b * S_ * 128;
    const u16* Vb = (br ? ((u16*)(p.ws + OFF_VWINt)) : ((u16*)(p.ws + OFF_VSELt))) + (long)b * 128 * S_;
    const int tlo = br ? ((q0 > 511 ? q0 - 511 : 0) >> 6) : 0;
    const int thi = cur;
#pragma unroll
    for (int db = 0; db < 4; ++db) o[db] = zero16();
    float m = -INFINITY, l = 0.f;
    k_fetch<16>(ks, Kb + (long)thi * 64 * 128, 128, nullptr, 0);
    v_fetch(vs, Vb + thi * 64, S_);
    hbar(hbc);
    k_commit<16, KLD>(ks, (u16*)smem);
    v_commit(vs, (u16*)(smem + AOFF_V0));
    if (thi > tlo) {
      k_fetch<16>(ks, Kb + (long)(thi - 1) * 64 * 128, 128, nullptr, 0);
      v_fetch(vs, Vb + (thi - 1) * 64, S_);
    }
    hbar(hbc);
    int cur = 0;
    for (int t = thi; t >= tlo; --t) {
      const u16* sKc = (const u16*)(smem + cur * AOFF_K1); const u16* sVc = (const u16*)(smem + AOFF_V0 + cur * (AOFF_V1 - AOFF_V0));
      u16* sKn = (u16*)(smem + (cur ^ 1) * AOFF_K1); u16* sVn = (u16*)(smem + AOFF_V0 + (cur ^ 1) * (AOFF_V1 - AOFF_V0));
      const int key0 = t * 64;
      f32x16 s0, s1;
      qk_tile<8, KLD>(sKc, qf, s0, s1, r, h);
      if (t > tlo) k_commit<16, KLD>(ks, sKn);
      const bool sel = br ? true : ((mybits >> t) & 1u);
      const bool interior = (key0 + 63 <= q0) && (br ? (key0 > q0 + 31 - 512) : (bool)__all(sel));
      if (!interior) {
#pragma unroll
        for (int i = 0; i < 16; ++i) {
          const int ka = key0 + crow(i, h), kb2 = ka + 32;
          bool v0 = sel && ka <= qpos, v1 = sel && kb2 <= qpos;
          if (br) { v0 = v0 && (ka > qpos - 512); v1 = v1 && (kb2 > qpos - 512); }
          s0[i] = v0 ? s0[i] : -INFINITY;
          s1[i] = v1 ? s1[i] : -INFINITY;
        }
      }
      softmax_step(s0, s1, m, l, o);
      if (t > tlo) {
        v_commit(vs, sVn);
        if (t - 1 > tlo) {
          k_fetch<16>(ks, Kb + (long)(t - 2) * 64 * 128, 128, nullptr, 0);
          v_fetch(vs, Vb + (t - 2) * 64, S_);
        }
      }
      pv_tile(sVc, s0, s1, o, r, h);
      hbar(hbc);
      cur ^= 1;
    }
    const float lt = l + __shfl_xor(l, 32);
    const float sc = (lt > 0.f ? 1.f / lt : 0.f) * (br ? gw : gsl);
    if (br == 0) {
#pragma unroll
      for (int db = 0; db < 4; ++db)
#pragma unroll
        for (int g = 0; g < 4; ++g) {
          f32x4 v = *(f32x4*)&Fp[db * 32 + 8 * g + 4 * h];
          v[0] += o[db][4 * g] * sc; v[1] += o[db][4 * g + 1] * sc; v[2] += o[db][4 * g + 2] * sc; v[3] += o[db][4 * g + 3] * sc;
          *(f32x4*)&Fp[db * 32 + 8 * g + 4 * h] = v;
        }
    } else {
#pragma unroll
      for (int db = 0; db < 4; ++db)
#pragma unroll
        for (int g = 0; g < 4; ++g) {
          const f32x4 v = *(f32x4*)&Fp[db * 32 + 8 * g + 4 * h];
          o[db][4 * g] = o[db][4 * g] * sc + v[0]; o[db][4 * g + 1] = o[db][4 * g + 1] * sc + v[1];
          o[db][4 * g + 2] = o[db][4 * g + 2] * sc + v[2]; o[db][4 * g + 3] = o[db][4 * g + 3] * sc + v[3];
        }
      store_mix(p, o, 1.f, (int)tq, 512 + wave * 128, h);
    }
  }
}

DI void phase_att(const P& p, int qidx, unsigned xcc, char* smem) {
  const int half = vhalf();
  char* hs = smem + half * HALF_BYTES;
  unsigned* hbc = (unsigned*)(hs + AOFF_HB);
  int* sItem = (int*)(hs + AOFF_ITEM);
  unsigned* ctr = ((unsigned*)(p.ws + OFF_ctr)) + XB_CTR + qidx * 8;
  __syncthreads();
  if (vtid() == 0) *hbc = 0u;
  __syncthreads();
  for (;;) {
    hbar(hbc);
    if (vtid() == 0) {
      int item = -1, qx = 0;
      for (int v = 0; v < 8; ++v) {
        const int xx = (int)((xcc + (unsigned)v) & 7u);
        if (xb_ld(&ctr[xx]) < 128u) {
          const unsigned got = atomicAdd(&ctr[xx], 1u);
          if (got < 128u) { item = (int)got; qx = xx; break; }
        }
      }
      sItem[0] = item; sItem[1] = qx;
    }
    hbar(hbc);
    const int li = sItem[0], x = sItem[1];
    if (li < 0) break;
    const int qb = 15 - (li >> 3), k = li & 7;
    if (k < 2) attn_causal_item<2>(p, 2 * x + k, qb, hs);
    else if (k < 4) attn_causal_item<1>(p, 2 * x + (k - 2), qb, hs);
    else if (k < 6) attn_causal_item<0>(p, 2 * x + (k - 4), qb, hs);
    else attn_nsa_item(p, x >> 1, qb * 128 + ((x & 1) * 2 + (k - 6)) * 32, hs);
  }
}

DI void phase_g2(const P& p, int layer, char* smem) {
  const u16* Wt = ((u16*)(p.ws + OFF_wt_out)) + (long)layer * D_ * D_;
  constexpr int TOT = 32 * 8;
  for (int t = blockIdx.x; t < TOT; t += gridDim.x) {
    const int xcd = t & 7, j = t >> 3;
    const int mt = xcd * 4 + (j & 3), tnb = j >> 2;
    const int m0 = mt * 256, n0 = tnb * 256;
    const u16* A = ((u16*)(p.ws + OFF_MIX)) + (long)m0 * D_;
    auto epi = [&](f32x16 (&acc)[4][2], int wr, int wc, int r, int h) {
#pragma unroll
      for (int i = 0; i < 4; ++i)
#pragma unroll
        for (int jj = 0; jj < 2; ++jj)
#pragma unroll
          for (int e = 0; e < 16; ++e) {
            const int m = m0 + wr * 128 + i * 32 + crow(e, h);
            ((u16*)(p.ws + OFF_Y))[(long)m * D_ + n0 + wc * 64 + jj * 32 + r] = f2bf(acc[i][jj][e]);
          }
    };
    gemm_tile<2, 4, 4, 2, 64, 512>(smem, A, D_, Wt + (long)n0 * D_, D_, D_, epi);
  }
}

DI void phase_norm(const P& p, int layer) {
  const int tid = vtid();
  const bool last = layer == 1;
  for (int it = blockIdx.x; it < T_ / 8; it += gridDim.x) {
    const int row = it * 8 + (opaque_tid() >> 6);
    norm_row(p, row, 1, layer == 0 ? p.x : ((float*)(p.ws + OFF_X1)), ((u16*)(p.ws + OFF_Y)), p.post_g + layer * D_, last ? p.out : ((float*)(p.ws + OFF_X1)),
             last ? nullptr : p.pre_g + (layer + 1) * D_, ((u16*)(p.ws + OFF_H)));
  }
}

__global__ void __launch_bounds__(NTHREADS, 2) hybrid_megakernel(P p) {
  __shared__ __attribute__((aligned(16))) char smem[SMEM_BYTES];
  __shared__ __attribute__((aligned(16))) unsigned xbst[4];
  unsigned* bar = (unsigned*)(p.ws + OFF_ctr);
  const unsigned xcc = xb_xcc_id();
  if (threadIdx.x == 0) { xbst[0] = 0u; xbst[1] = 0u; (void)xb_add(&bar[XB_XCNT(xcc)], 1u); }
  __syncthreads();
  for (int ph = p.phase_lo; ph < p.phase_hi; ++ph) {
    if (ph > p.phase_lo) {
      if (p.phase_lo < 0) cg::this_grid().sync();
      xcd_barrier(bar, xcc, xbst);
    }
    if (ph == 0) {
      phase0(p, smem);
#if DUP_SUB == 9
      xcd_barrier(bar, xcc, xbst); phase0(p, smem);
#endif
      continue;
    }
    const int layer = (ph - 1) / 5, sub = (ph - 1) % 5;
    for (int rep = 0; rep < (sub == DUP_SUB ? 2 : 1); ++rep) {
      if (rep) xcd_barrier(bar, xcc, xbst);
      if (sub == 0) phase_g1(p, layer, smem);
      else if (sub == 1) phase_prep(p, layer, smem);
      else if (sub == 2) phase_att(p, layer + 2 * rep, xcc, smem);
      else if (sub == 3) phase_g2(p, layer, smem);
      else phase_norm(p, layer);
    }
  }
}

extern "C" void kernel_launch(void* const* d_in, const int* in_sizes, int n_in, void* d_out, int out_size, void* d_ws, size_t ws_size,
                              hipStream_t stream) {
  static int grid_blocks = 0;
  if (!grid_blocks) {
    int dev = 0, cus = 0, per_cu = 0;
    hipGetDevice(&dev);
    hipDeviceGetAttribute(&cus, hipDeviceAttributeMultiprocessorCount, dev);
    hipOccupancyMaxActiveBlocksPerMultiprocessor(&per_cu, hybrid_megakernel, NTHREADS, 0);
    if (per_cu > 1) per_cu = 1;
    if (per_cu < 1) per_cu = 1;
    grid_blocks = cus * per_cu;
  }
  P p{};
  p.x = (const float*)d_in[0]; p.pre_g = (const float*)d_in[1]; p.post_g = (const float*)d_in[2]; p.w_in = (const float*)d_in[3];
  p.b_in = (const float*)d_in[4]; p.w_out = (const float*)d_in[5]; p.fb = (const float*)d_in[6]; p.pos_k = (const float*)d_in[7];
  p.w1_k = (const float*)d_in[8]; p.w2_k = (const float*)d_in[9]; p.pos_v = (const float*)d_in[10]; p.w1_v = (const float*)d_in[11];
  p.w2_v = (const float*)d_in[12]; p.qn_g = (const float*)d_in[13]; p.w_uq = (const float*)d_in[14]; p.kvn_g = (const float*)d_in[15];
  p.w_ukv = (const float*)d_in[16];
  p.out = (float*)d_out;
  p.ws = (char*)d_ws;
  p.phase_lo = 0; p.phase_hi = 11;
  hipMemsetAsync((char*)d_ws + OFF_ctr, 0, XCD_BAR_WORDS * sizeof(unsigned), stream);
  void* args[] = {&p};
  hipError_t e = hipLaunchCooperativeKernel((void*)hybrid_megakernel, dim3(grid_blocks), dim3(NTHREADS), args, 0, stream);
  if (e != hipSuccess) fprintf(stderr, "cooperative launch failed: %s (grid %d)\n", hipGetErrorString(e), grid_blocks);
}
```
